# Optimizing an MI355X kernel written in HIP

```python
import math
import jax, jax.numpy as jnp
from jax import lax
import numpy as np

D_MODEL = 1024
BATCH = 4
SEQ = 8192
DEPTH = 2

HEAD_DIM = 64
MEM_LEN = 256
MEM_HEADS = 4
MEM_WIDTH = MEM_HEADS * HEAD_DIM
MIX_WIDTH = D_MODEL
TOK_WIDTH = MIX_WIDTH - MEM_WIDTH
FOX_HEADS = TOK_WIDTH // HEAD_DIM
GMLP_GROUPS = TOK_WIDTH // HEAD_DIM
CHUNK = 128
Q_BLOCK = 128
D_FF = 2816
N_MIXERS = 2
N_FOX = (DEPTH + 1) // 2
N_GMLP = DEPTH // 2
FOX_IN = 3 * TOK_WIDTH + FOX_HEADS + MEM_WIDTH
GMLP_IN = 2 * TOK_WIDTH + MEM_WIDTH
EPS = 1e-6

kernel_name = "hybrid_fox_gmlp_macaron_memxattn"


def rms_norm(x, g):
    xf = x.astype(jnp.float32)
    y = xf * lax.rsqrt(jnp.mean(xf * xf, axis=-1, keepdims=True) + EPS)
    return (y * g.astype(jnp.float32)).astype(x.dtype)


def swiglu(h, w_in, w_out):
    a, b = jnp.split(h @ w_in, 2, axis=-1)
    return (jax.nn.silu(a) * b) @ w_out


def memory_attention(mq, mem_n, w_kv, g_q, g_k):
    b, s, _ = mq.shape
    q = rms_norm(mq.reshape(b, s, MEM_HEADS, HEAD_DIM), g_q)
    kv = mem_n @ w_kv
    k, v = jnp.split(kv, 2, axis=-1)
    k = rms_norm(k.reshape(b, MEM_LEN, MEM_HEADS, HEAD_DIM), g_k)
    v = v.reshape(b, MEM_LEN, MEM_HEADS, HEAD_DIM)
    logits = jnp.einsum('bshd,bmhd->bhsm', q, k).astype(jnp.float32) / math.sqrt(HEAD_DIM)
    p = jax.nn.softmax(logits, axis=-1).astype(v.dtype)
    o = jnp.einsum('bhsm,bmhd->bshd', p, v)
    return o.reshape(b, s, MEM_WIDTH)


def forgetting_attention(q, k, v, c):
    b, s, h, d = q.shape
    nblk = s // Q_BLOCK
    qb = q.reshape(b, nblk, Q_BLOCK, h, d).transpose(1, 0, 2, 3, 4)
    cq = c.reshape(b, h, nblk, Q_BLOCK).transpose(2, 0, 1, 3)
    starts = jnp.arange(nblk, dtype=jnp.int32) * Q_BLOCK
    key_pos = jnp.arange(s, dtype=jnp.int32)
    scale = 1.0 / math.sqrt(d)

    def block(args):
        q_i, c_i, start = args
        logits = jnp.einsum('bqhd,bkhd->bhqk', q_i, k).astype(jnp.float32) * scale
        logits = logits + c_i[:, :, :, None] - c[:, :, None, :]
        q_pos = start + jnp.arange(Q_BLOCK, dtype=jnp.int32)
        mask = key_pos[None, :] <= q_pos[:, None]
        logits = jnp.where(mask[None, None], logits, -jnp.inf)
        p = jax.nn.softmax(logits, axis=-1).astype(v.dtype)
        return jnp.einsum('bhqk,bkhd->bqhd', p, v)

    out = lax.map(block, (qb, cq, starts))
    return out.transpose(1, 0, 2, 3, 4).reshape(b, s, h * d)


def fox_token_mixer(proj, b_f, g_q, g_k):
    b, s, _ = proj.shape
    t = TOK_WIDTH
    q = rms_norm(proj[..., :t].reshape(b, s, FOX_HEADS, HEAD_DIM), g_q)
    k = rms_norm(proj[..., t:2 * t].reshape(b, s, FOX_HEADS, HEAD_DIM), g_k)
    v = proj[..., 2 * t:3 * t].reshape(b, s, FOX_HEADS, HEAD_DIM)
    f_logit = proj[..., 3 * t:3 * t + FOX_HEADS].astype(jnp.float32) + b_f.astype(jnp.float32)
    log_f = jax.nn.log_sigmoid(f_logit)
    c = jnp.cumsum(log_f, axis=1).transpose(0, 2, 1)
    mq = proj[..., 3 * t + FOX_HEADS:]
    return forgetting_attention(q, k, v, c), mq


def gmlp_token_mixer(proj, v_gain, w_s, b_s):
    b, s, _ = proj.shape
    t = TOK_WIDTH
    z = jax.nn.gelu(proj[..., :2 * t])
    u, v = z[..., :t], z[..., t:]
    v = rms_norm(v.reshape(b, s, GMLP_GROUPS, HEAD_DIM), v_gain.reshape(GMLP_GROUPS, HEAD_DIM))
    n_chunk = s // CHUNK
    vc = v.reshape(b, n_chunk, CHUNK, GMLP_GROUPS, HEAD_DIM)
    w = jnp.tril(w_s)
    gate = jnp.einsum('gts,bcsgd->bctgd', w, vc) + b_s.T[None, None, :, :, None]
    out = u.reshape(b, n_chunk, CHUNK, GMLP_GROUPS, HEAD_DIM) * gate
    return out.reshape(b, s, t), proj[..., 2 * t:]


def setup_inputs(seed: int = 0) -> dict:
    key = jax.random.key(seed)
    ks = jax.random.split(key, 32)
    f32 = jnp.float32
    D, F = D_MODEL, D_FF

    def nrm(k, shape, scale):
        return jax.random.normal(k, shape, f32) * scale

    def gain(k, shape):
        return 1.0 + 0.02 * jax.random.normal(k, shape, f32)

    return {
        "x": jax.random.normal(ks[0], (BATCH, SEQ, D), f32),
        "mem": jax.random.normal(ks[1], (BATCH, MEM_LEN, D), f32),
        "norm_ffn1": gain(ks[2], (DEPTH, D)),
        "ffn1_w_in": nrm(ks[3], (DEPTH, D, 2 * F), D ** -0.5),
        "ffn1_w_out": nrm(ks[4], (DEPTH, F, D), F ** -0.5),
        "norm_mix": gain(ks[5], (DEPTH, D)),
        "norm_ffn2": gain(ks[6], (DEPTH, D)),
        "ffn2_w_in": nrm(ks[7], (DEPTH, D, 2 * F), D ** -0.5),
        "ffn2_w_out": nrm(ks[8], (DEPTH, F, D), F ** -0.5),
        "w_out": nrm(ks[9], (DEPTH, MIX_WIDTH, D), MIX_WIDTH ** -0.5),
        "mem_norm": gain(ks[10], (D,)),
        "mem_w_kv": nrm(ks[11], (DEPTH, D, 2 * MEM_WIDTH), D ** -0.5),
        "mem_q_norm": gain(ks[12], (DEPTH, HEAD_DIM)),
        "mem_k_norm": gain(ks[13], (DEPTH, HEAD_DIM)),
        "fox_w_in": nrm(ks[14], (N_FOX, D, FOX_IN), D ** -0.5),
        "fox_b_f": 2.0 + 4.0 * jax.random.uniform(ks[15], (N_FOX, FOX_HEADS), f32),
        "fox_q_norm": gain(ks[16], (N_FOX, HEAD_DIM)),
        "fox_k_norm": gain(ks[17], (N_FOX, HEAD_DIM)),
        "gmlp_w_in": nrm(ks[18], (N_GMLP, D, GMLP_IN), D ** -0.5),
        "gmlp_v_norm": gain(ks[19], (N_GMLP, TOK_WIDTH)),
        "gmlp_w_s": nrm(ks[20], (N_GMLP, GMLP_GROUPS, CHUNK, CHUNK), 0.5 * CHUNK ** -0.5),
        "gmlp_b_s": 1.0 + 0.02 * jax.random.normal(ks[21], (N_GMLP, GMLP_GROUPS, CHUNK), f32),
    }


def reference(x, mem, norm_ffn1, ffn1_w_in, ffn1_w_out, norm_mix, norm_ffn2, ffn2_w_in,
              ffn2_w_out, w_out, mem_norm, mem_w_kv, mem_q_norm, mem_k_norm, fox_w_in,
              fox_b_f, fox_q_norm, fox_k_norm, gmlp_w_in, gmlp_v_norm, gmlp_w_s, gmlp_b_s):
    mem_n = rms_norm(mem, mem_norm)
    for i in range(DEPTH):
        kind, j = i % N_MIXERS, i // N_MIXERS
        x = x + 0.5 * swiglu(rms_norm(x, norm_ffn1[i]), ffn1_w_in[i], ffn1_w_out[i])
        h = rms_norm(x, norm_mix[i])
        if kind == 0:
            tok, mq = fox_token_mixer(h @ fox_w_in[j], fox_b_f[j], fox_q_norm[j], fox_k_norm[j])
        else:
            tok, mq = gmlp_token_mixer(h @ gmlp_w_in[j], gmlp_v_norm[j], gmlp_w_s[j], gmlp_b_s[j])
        mo = memory_attention(mq, mem_n, mem_w_kv[i], mem_q_norm[i], mem_k_norm[i])
        x = x + jnp.concatenate([tok, mo], axis=-1) @ w_out[i]
        x = x + 0.5 * swiglu(rms_norm(x, norm_ffn2[i]), ffn2_w_in[i], ffn2_w_out[i])
    return x
```

```cpp
#include <hip/hip_runtime.h>
#include <hip/hip_cooperative_groups.h>
#include <hip/hip_bf16.h>
#include <cstdio>
#include <cstdint>
#include <cmath>
namespace cg = cooperative_groups;
namespace pg8 {
#define PG8_LAS __attribute__((address_space(3)))
typedef unsigned short bf16_t;
typedef short bf16x8 __attribute__((ext_vector_type(8)));
typedef float f32x4 __attribute__((ext_vector_type(4)));
typedef unsigned u32x4 __attribute__((ext_vector_type(4)));
constexpr int BM = 256, BK = 64, HALF = 128, HTB = HALF * BK * 2  , STAGE_BYTES = 8 * HTB, NXCD = 8, WGM = 8;

__host__ __device__ __forceinline__ int lds_byte(int r, int c) { const int st = (r >> 4) * 2 + (c >> 5), rr = r & 15, cc = c & 31, ob = rr * 64 + cc * 2; return st * 1024 + (ob ^ (((ob >> 9) & 1) << 5)); }
__host__ __device__ __forceinline__ void stage_rc(int b, int& R, int& C) { const int st = b / 1024, sb = b % 1024, swz = sb ^ (((sb >> 9) & 1) << 5); R = (st >> 1) * 16 + swz / 64; C = (st & 1) * 32 + (swz % 64) / 2; }
__host__ __device__ __forceinline__ int perm32(int rho) { const int n = rho >> 4, i = rho & 15; return 8 * (i >> 2) + 4 * n + (i & 3); }

struct Unit { int pm, pn; };
struct Gemm { const bf16_t* A; const bf16_t* Bt; int M, N, K; };

struct StaticOrder {
    int nM, nN, nwg, G, c;
    __host__ __device__ void init(int M, int N, int G_, int c_) { nM = M / BM; nN = N / BM; nwg = nM * nN; G = G_; c = c_; }
    __host__ __device__ bool next(int i, Unit& u) const {
        const long L = (long)i * G + c; if (L >= nwg) return false;
        int wgid = (int)L; { const int q = nwg / NXCD, r = nwg % NXCD, xcd = wgid % NXCD, off = wgid / NXCD; wgid = (xcd < r ? xcd * (q + 1) : r * (q + 1) + (xcd - r) * q) + off; }
        const int nig = WGM * nN, gid = wgid / nig, fm = gid * WGM, gsz = (nM - fm) < WGM ? (nM - fm) : WGM;
        u.pm = fm + ((wgid % nig) % gsz); u.pn = (wgid % nig) / gsz; return true;
    }
    __device__ __forceinline__ void a_ready(const Unit&) const {}
    __device__ __forceinline__ void done(const Unit&) const {}
};
__device__ __forceinline__ unsigned cvt_pk_bf16(float lo, float hi) { unsigned r; asm volatile("v_cvt_pk_bf16_f32 %0, %1, %2" : "=v"(r) : "v"(lo), "v"(hi)); return r; }
typedef float f32x2 __attribute__((ext_vector_type(2)));
typedef unsigned u32x2 __attribute__((ext_vector_type(2)));
__device__ __forceinline__ float mul_sigmoid(float v, float z) { return v * __builtin_amdgcn_rcpf(1.0f + __builtin_amdgcn_exp2f(-1.4426950408889634f * z)); }
__device__ __forceinline__ float gelu_tanh(float v) { return mul_sigmoid(v, 1.5957691216057308f * (v + 0.044715f * v * v * v)); }
constexpr float ATT_C2 = 0.125f * 1.4426950408889634f;

struct EpiSwiGLU {
    static constexpr bool PERM = true, AFTER_DRAIN = false;
    bf16_t* O; int ldc; const float* ssq;
    __device__ __forceinline__ void operator()(const f32x4 (&acc)[2][2][4][2], const Unit& u, int wr, int wc, int fr, int fq) const {
        const int row0 = u.pm * BM + wr * 64 + fr; const int col0 = u.pn * 128 + wc * 32 + 8 * fq;
#pragma unroll
        for (int ai = 0; ai < 2; ++ai)
#pragma unroll
            for (int m = 0; m < 4; ++m) {
                bf16_t* p = O + (size_t)(row0 + ai * HALF + m * 16) * ldc + col0;
                const float rs = __builtin_amdgcn_rsqf(ssq[row0 + ai * HALF + m * 16] * (1.0f / 1024.0f) + 1e-6f);
                const f32x4 a0 = acc[ai][0][m][0] * rs, a1 = acc[ai][0][m][1] * rs, b0 = acc[ai][1][m][0] * rs, b1 = acc[ai][1][m][1] * rs;
                u32x4 w;
                w.x = cvt_pk_bf16(mul_sigmoid(a0[0], a0[0]) * b0[0], mul_sigmoid(a0[1], a0[1]) * b0[1]);
                w.y = cvt_pk_bf16(mul_sigmoid(a0[2], a0[2]) * b0[2], mul_sigmoid(a0[3], a0[3]) * b0[3]);
                w.z = cvt_pk_bf16(mul_sigmoid(a1[0], a1[0]) * b1[0], mul_sigmoid(a1[1], a1[1]) * b1[1]);
                w.w = cvt_pk_bf16(mul_sigmoid(a1[2], a1[2]) * b1[2], mul_sigmoid(a1[3], a1[3]) * b1[3]);
                *(u32x4*)p = w;
            }
    }
};
template <bool WXB> struct EpiRes {
    static constexpr bool PERM = true, AFTER_DRAIN = false;
    const float* xin; float* xout; bf16_t* xb; float* ssq; float s;
    __device__ __forceinline__ void operator()(const f32x4 (&acc)[2][2][4][2], const Unit& u, int wr, int wc, int fr, int fq) const {
        const int row0 = u.pm * BM + wr * 64 + fr; const int col0 = u.pn * BM + wc * 32 + 8 * fq;
#pragma unroll
        for (int ai = 0; ai < 2; ++ai)
#pragma unroll
            for (int m = 0; m < 4; ++m) {
                const int row = row0 + ai * HALF + m * 16; const size_t off = (size_t)row * 1024 + col0; float ss = 0.f;
#pragma unroll
                for (int bj = 0; bj < 2; ++bj) {
                    const f32x4 o0 = *(const f32x4*)(xin + off + bj * HALF) + acc[ai][bj][m][0] * s, o1 = *(const f32x4*)(xin + off + bj * HALF + 4) + acc[ai][bj][m][1] * s;
                    __builtin_nontemporal_store(o0, (f32x4*)(xout + off + bj * HALF)); __builtin_nontemporal_store(o1, (f32x4*)(xout + off + bj * HALF + 4));
                    if (WXB) { u32x4 w; w.x = cvt_pk_bf16(o0[0], o0[1]); w.y = cvt_pk_bf16(o0[2], o0[3]); w.z = cvt_pk_bf16(o1[0], o1[1]); w.w = cvt_pk_bf16(o1[2], o1[3]); *(u32x4*)(xb + off + bj * HALF) = w;
                        ss += ((o0[0] * o0[0] + o0[1] * o0[1]) + (o0[2] * o0[2] + o0[3] * o0[3])) + ((o1[0] * o1[0] + o1[1] * o1[1]) + (o1[2] * o1[2] + o1[3] * o1[3])); }
                }
                if (WXB) { ss += __shfl_xor(ss, 16); ss += __shfl_xor(ss, 32); if (fq == 0) unsafeAtomicAdd(ssq + row, ss); }
            }
    }
};
template <int KIND> struct EpiProj {
    static constexpr bool PERM = true, AFTER_DRAIN = false;
    bf16_t* O; int ldc; const float* gq; const float* gk; const float* gm; const float* ssq;
    __device__ __forceinline__ void operator()(const f32x4 (&acc)[2][2][4][2], const Unit& u, int wr, int wc, int fr, int fq) const {
        int mode = 0; const float* g = gk; float sc = 1.f; const int pn = u.pn;
        if (KIND == 0) { if (pn < 3) { mode = 1; g = gq; sc = ATT_C2; } else if (pn < 6) { mode = 1; g = gk; } else if (pn < 9) { mode = 0; } else { mode = 1; g = gm; sc = ATT_C2; } }
        else if (KIND == 1) { if (pn < 3) { mode = 2; } else if (pn < 6) { mode = 3; g = gk + (4 * (pn - 3) + wc) * 64; } else { mode = 1; g = gm; sc = ATT_C2; } }
        else { if (pn == 0) { mode = 1; g = gk; } else { mode = 0; } }
        f32x4 gv[2][2];
#pragma unroll
        for (int bj = 0; bj < 2; ++bj)
#pragma unroll
            for (int n = 0; n < 2; ++n) gv[bj][n] = (mode & 1) ? *(const f32x4*)(g + 32 * bj + 8 * fq + 4 * n) * sc : (f32x4){1.f, 1.f, 1.f, 1.f};
        const int row0 = u.pm * BM + wr * 64 + fr; const int col0 = pn * BM + wc * 64 + 8 * fq;
#pragma unroll
        for (int ai = 0; ai < 2; ++ai)
#pragma unroll
            for (int m = 0; m < 4; ++m) {
                f32x4 v[2][2];
#pragma unroll
                for (int bj = 0; bj < 2; ++bj)
#pragma unroll
                    for (int n = 0; n < 2; ++n) v[bj][n] = acc[ai][bj][m][n];
                if (KIND != 2) { const float rs = __builtin_amdgcn_rsqf(ssq[row0 + ai * HALF + m * 16] * (1.0f / 1024.0f) + 1e-6f);
#pragma unroll
                    for (int bj = 0; bj < 2; ++bj)
#pragma unroll
                        for (int n = 0; n < 2; ++n) v[bj][n] = v[bj][n] * rs; }
                if (mode & 2) {
#pragma unroll
                    for (int bj = 0; bj < 2; ++bj)
#pragma unroll
                        for (int n = 0; n < 2; ++n)
#pragma unroll
                            for (int e = 0; e < 4; ++e) v[bj][n][e] = gelu_tanh(v[bj][n][e]);
                }
                if (mode & 1) {
                    float ss = 0.f;
#pragma unroll
                    for (int bj = 0; bj < 2; ++bj)
#pragma unroll
                        for (int n = 0; n < 2; ++n) { const f32x4 x = v[bj][n]; ss += (x[0] * x[0] + x[1] * x[1]) + (x[2] * x[2] + x[3] * x[3]); }
                    ss += __shfl_xor(ss, 16); ss += __shfl_xor(ss, 32);
                    const float r = __builtin_amdgcn_rsqf(ss * (1.0f / 64.0f) + 1e-6f);
#pragma unroll
                    for (int bj = 0; bj < 2; ++bj)
#pragma unroll
                        for (int n = 0; n < 2; ++n) v[bj][n] = v[bj][n] * r * gv[bj][n];
                }
                bf16_t* p = O + (size_t)(row0 + ai * HALF + m * 16) * ldc + col0;
#pragma unroll
                for (int bj = 0; bj < 2; ++bj) {
                    u32x4 w; w.x = cvt_pk_bf16(v[bj][0][0], v[bj][0][1]); w.y = cvt_pk_bf16(v[bj][0][2], v[bj][0][3]); w.z = cvt_pk_bf16(v[bj][1][0], v[bj][1][1]); w.w = cvt_pk_bf16(v[bj][1][2], v[bj][1][3]);
                    *(u32x4*)(p + 32 * bj) = w;
                }
            }
    }
};
template <class Epi, class Sched, bool ALIGN_EPI = false, bool SP2 = false>
__device__ __forceinline__ void gemm_phase(PG8_LAS unsigned char* lds, const Gemm g, const Sched& S, const Epi& E) {
    int tid_l = threadIdx.x; asm volatile("" : "+v"(tid_l));
    const int tid = tid_l, wid = __builtin_amdgcn_readfirstlane(tid >> 6), lane = tid & 63, wr = wid >> 2, wc = wid & 3, fr = lane & 15, fq = lane >> 4;
    const int K = g.K, nt = K / BK;
    unsigned voffA[2], voffB[2];
#pragma unroll
    for (int i = 0; i < 2; ++i) { int R, C; stage_rc(tid * 16 + i * 8192, R, C); const int Rb = Epi::PERM ? ((R & ~31) + perm32(R & 31)) : R;
        voffA[i] = (unsigned)(R * K + C) * 2u; voffB[i] = (unsigned)(Rb * K + C) * 2u; }
    const size_t kstep = (size_t)(BK * 2);
    const size_t hstep = (size_t)HALF * K * 2;
    const size_t tstep = 2 * hstep;
    const unsigned ldsw = (unsigned)wid * 1024u;
    const int aoff = lds_byte(wr * 64 + fr, fq * 8), boff = lds_byte(wc * 32 + fr, fq * 8);
#define PG8_SA(b, h) (((b) * 2 + (h)) * HTB)
#define PG8_SB(b, h) ((4 + (b) * 2 + (h)) * HTB)
#define PG8_STAGE(bufoff, gbase, voff) do { _Pragma("unroll") for (int _i = 0; _i < 2; ++_i) \
        __builtin_amdgcn_global_load_lds((const unsigned*)((const char*)(gbase) + (voff)[_i]), (PG8_LAS unsigned*)(lds + (bufoff) + ldsw + _i * 8192), 16, 0, 0); } while (0)
#define PG8_LDA(dst, b, h) do { _Pragma("unroll") for (int m = 0; m < 4; ++m) _Pragma("unroll") for (int k = 0; k < 2; ++k) dst[m][k] = *(const PG8_LAS bf16x8*)(lds + PG8_SA(b, h) + aoff + m * 2048 + k * 1024); } while (0)
#define PG8_LDB(dst, b, h) do { _Pragma("unroll") for (int n = 0; n < 2; ++n) _Pragma("unroll") for (int k = 0; k < 2; ++k) dst[n][k] = *(const PG8_LAS bf16x8*)(lds + PG8_SB(b, h) + boff + n * 2048 + k * 1024); } while (0)
#define PG8_MMA(ai, bj, At, Bt) do { __builtin_amdgcn_s_setprio(1); _Pragma("unroll") for (int m = 0; m < 4; ++m) _Pragma("unroll") for (int n = 0; n < 2; ++n) _Pragma("unroll") for (int k = 0; k < 2; ++k) \
        acc[ai][bj][m][n] = __builtin_amdgcn_mfma_f32_16x16x32_bf16(Bt[n][k], At[m][k], acc[ai][bj][m][n], 0, 0, 0); __builtin_amdgcn_s_setprio(0); } while (0)
#define PG8_WAIT_V(n) asm volatile("s_waitcnt vmcnt(" #n ")" ::: "memory")
#define PG8_WAIT_L(n) asm volatile("s_waitcnt lgkmcnt(" #n ")" ::: "memory")
#define PG8_BAR __builtin_amdgcn_s_barrier()
#define PG8_SCHED __builtin_amdgcn_sched_barrier(0)
    Unit cur, nxt; int ui = 0;
    if (!S.next(0, cur)) return;
    f32x4 acc[2][2][4][2];
#pragma unroll
    for (int a = 0; a < 2; ++a)
#pragma unroll
        for (int b = 0; b < 2; ++b)
#pragma unroll
            for (int m = 0; m < 4; ++m)
#pragma unroll
                for (int n = 0; n < 2; ++n) acc[a][b][m][n] = (f32x4){0.f, 0.f, 0.f, 0.f};
    bf16x8 At[4][2], B0[2][2], B1[2][2];
    const char* cA = (const char*)g.A + (size_t)cur.pm * tstep; const char* cB = (const char*)g.Bt + (size_t)cur.pn * tstep;
    S.a_ready(cur);
    if constexpr (SP2) {
        PG8_STAGE(PG8_SB(0, 0), cB, voffB); PG8_STAGE(PG8_SB(0, 1), cB + hstep, voffB); PG8_STAGE(PG8_SA(0, 0), cA, voffA); PG8_STAGE(PG8_SA(0, 1), cA + hstep, voffA);
        if (wr == 1) PG8_BAR;
        PG8_WAIT_V(2); PG8_BAR;
        PG8_STAGE(PG8_SB(1, 0), cB + kstep, voffB); PG8_STAGE(PG8_SA(1, 0), cA + kstep, voffA); PG8_STAGE(PG8_SB(1, 1), cB + hstep + kstep, voffB);
        PG8_WAIT_V(6); PG8_BAR;
    } else {
        PG8_STAGE(PG8_SB(0, 0), cB, voffB); PG8_STAGE(PG8_SA(0, 0), cA, voffA); PG8_STAGE(PG8_SB(0, 1), cB + hstep, voffB); PG8_STAGE(PG8_SA(0, 1), cA + hstep, voffA);
        if (wr == 1) PG8_BAR;
        PG8_WAIT_V(4); PG8_BAR;
        PG8_STAGE(PG8_SB(1, 0), cB + kstep, voffB); PG8_STAGE(PG8_SA(1, 0), cA + kstep, voffA); PG8_STAGE(PG8_SB(1, 1), cB + hstep + kstep, voffB);
        PG8_WAIT_V(6); PG8_BAR;
    }
    for (;;) {
        const bool has_next = S.next(ui + 1, nxt);
        const char* nA = has_next ? (const char*)g.A + (size_t)nxt.pm * tstep : cA; const char* nB = has_next ? (const char*)g.Bt + (size_t)nxt.pn * tstep : cB;
        for (int t = 0; t < nt; t += 2) {
            const bool last = (t == nt - 2);
            const char* a1 = cA + (size_t)(t + 1) * kstep;
            const char* a2 = last ? nA : cA + (size_t)(t + 2) * kstep; const char* b2 = last ? nB : cB + (size_t)(t + 2) * kstep;
            const char* a3 = a2 + kstep; const char* b3 = b2 + kstep;
            if (last && has_next) S.a_ready(nxt);
            if constexpr (SP2) {
            PG8_LDB(B0, 0, 0); PG8_LDB(B1, 0, 1); PG8_SCHED; PG8_LDA(At, 0, 0); PG8_STAGE(PG8_SA(1, 1), a1 + hstep, voffA);
            PG8_WAIT_V(8); PG8_WAIT_L(0); PG8_BAR; PG8_MMA(0, 0, At, B0); PG8_MMA(0, 1, At, B1); PG8_BAR; PG8_SCHED;
            PG8_LDA(At, 0, 1); PG8_STAGE(PG8_SB(0, 0), b2, voffB); PG8_STAGE(PG8_SB(0, 1), b2 + hstep, voffB); PG8_STAGE(PG8_SA(0, 0), a2, voffA);
            PG8_WAIT_V(8); PG8_WAIT_L(0); PG8_BAR; PG8_MMA(1, 0, At, B0); PG8_MMA(1, 1, At, B1); PG8_BAR; PG8_SCHED;
            PG8_LDB(B0, 1, 0); PG8_LDB(B1, 1, 1); PG8_SCHED; PG8_LDA(At, 1, 0); PG8_STAGE(PG8_SA(0, 1), a2 + hstep, voffA);
            PG8_WAIT_V(8); PG8_WAIT_L(0); PG8_BAR; PG8_MMA(0, 0, At, B0); PG8_MMA(0, 1, At, B1); PG8_BAR; PG8_SCHED;
            PG8_LDA(At, 1, 1); PG8_STAGE(PG8_SB(1, 0), b3, voffB); PG8_STAGE(PG8_SB(1, 1), b3 + hstep, voffB); PG8_STAGE(PG8_SA(1, 0), a3, voffA);
            PG8_WAIT_V(8); PG8_WAIT_L(0); PG8_BAR; PG8_MMA(1, 0, At, B0); PG8_MMA(1, 1, At, B1); PG8_BAR; PG8_SCHED;
            } else {
            PG8_LDB(B0, 0, 0); PG8_SCHED; PG8_LDA(At, 0, 0); PG8_STAGE(PG8_SA(1, 1), a1 + hstep, voffA);
            PG8_WAIT_L(8); PG8_BAR; PG8_WAIT_L(0); PG8_MMA(0, 0, At, B0); PG8_BAR; PG8_SCHED;
            PG8_LDB(B1, 0, 1); PG8_STAGE(PG8_SB(0, 0), b2, voffB);
            PG8_BAR; PG8_WAIT_L(0); PG8_MMA(0, 1, At, B1); PG8_BAR;
            PG8_LDA(At, 0, 1); PG8_STAGE(PG8_SA(0, 0), a2, voffA);
            PG8_BAR; PG8_WAIT_L(0); PG8_MMA(1, 0, At, B0); PG8_BAR; PG8_SCHED;
            PG8_STAGE(PG8_SB(0, 1), b2 + hstep, voffB);
            PG8_WAIT_V(6); PG8_BAR; PG8_MMA(1, 1, At, B1); PG8_BAR;
            PG8_LDB(B0, 1, 0); PG8_SCHED; PG8_LDA(At, 1, 0); PG8_STAGE(PG8_SA(0, 1), a2 + hstep, voffA);
            PG8_WAIT_L(8); PG8_BAR; PG8_WAIT_L(0); PG8_MMA(0, 0, At, B0); PG8_BAR; PG8_SCHED;
            PG8_LDB(B1, 1, 1); PG8_STAGE(PG8_SB(1, 0), b3, voffB);
            PG8_BAR; PG8_WAIT_L(0); PG8_MMA(0, 1, At, B1); PG8_BAR;
            PG8_LDA(At, 1, 1); PG8_STAGE(PG8_SA(1, 0), a3, voffA);
            PG8_BAR; PG8_WAIT_L(0); PG8_MMA(1, 0, At, B0); PG8_BAR; PG8_SCHED;
            PG8_STAGE(PG8_SB(1, 1), b3 + hstep, voffB);
            PG8_WAIT_V(6); PG8_BAR; PG8_MMA(1, 1, At, B1); PG8_BAR;
            }
        }
        if constexpr (ALIGN_EPI) { if (wr == 0) PG8_BAR; }
        if constexpr (!Epi::AFTER_DRAIN) { E(acc, cur, wr, wc, fr, fq); S.done(cur); }
        if (!has_next) break;
#pragma unroll
        for (int a = 0; a < 2; ++a)
#pragma unroll
            for (int b = 0; b < 2; ++b)
#pragma unroll
                for (int m = 0; m < 4; ++m)
#pragma unroll
                    for (int n = 0; n < 2; ++n) acc[a][b][m][n] = (f32x4){0.f, 0.f, 0.f, 0.f};
        cur = nxt; cA = nA; cB = nB; ++ui;
        if constexpr (ALIGN_EPI) { if (wr == 1) PG8_BAR; }
    }
    PG8_WAIT_V(0);
    if constexpr (!ALIGN_EPI) { if (wr == 0) PG8_BAR; }
    PG8_BAR;
    if constexpr (Epi::AFTER_DRAIN) { E.fused(acc, cur, wr, wc, fr, fq, lds, wid, lane); S.done(cur); }
#undef PG8_SA
#undef PG8_SB
#undef PG8_STAGE
#undef PG8_LDA
#undef PG8_LDB
#undef PG8_MMA
#undef PG8_WAIT_V
#undef PG8_WAIT_L
#undef PG8_BAR
#undef PG8_SCHED
}
}
#include <hip/hip_bf16.h>
#include <cmath>
namespace attn_body {
using bf16=__hip_bfloat16;
using bf16x8=__attribute__((ext_vector_type(8)))short;
using s16x4=__attribute__((ext_vector_type(4)))short;
using f32x16=__attribute__((ext_vector_type(16)))float;
using u32x4=__attribute__((ext_vector_type(4)))unsigned;
using f32x4v=__attribute__((ext_vector_type(4)))float;
constexpr int D=64;
constexpr int NW=8,QBLK=32,QB=QBLK*NW,KVBLK=64;
__device__ __forceinline__ int crow(int r,int hi){return (r&3)+8*(r>>2)+4*hi;}
#define SBAR() __builtin_amdgcn_sched_barrier(0)
__device__ __forceinline__ void cmask(f32x16&p0,f32x16&p1,int jb,int qrel,int hi){
  const float NEG=-INFINITY; int kb=64*jb+4*hi;
  #pragma unroll
  for(int r=0;r<16;++r){int kv=kb+(r&3)+8*(r>>2); if(kv>qrel)p0[r]=NEG; if(kv+32>qrel)p1[r]=NEG;}
}

constexpr int NSLOT=3, SLOTB=8192;
constexpr int LDS_K=0, LDS_V=NSLOT*SLOTB, LDS_WS=2*NSLOT*SLOTB, LDS_OST=LDS_WS+NW*64*4, LDS_BIAS=LDS_OST+NW*4096, LDS_BYTES=LDS_BIAS+32768;
constexpr float C2=0.125f*1.4426950408889634f;
__device__ __forceinline__ void glds16(const void*gsrc,unsigned lds_dst){unsigned keep;
  asm volatile("s_mov_b32 %0, m0\n\ts_mov_b32 m0, %2\n\ts_nop 0\n\tglobal_load_lds_dwordx4 %1, off\n\ts_mov_b32 m0, %0":"=&s"(keep):"v"(gsrc),"s"(lds_dst):"memory");}
__device__ __forceinline__ float max3f(float a,float b,float c){float r;asm("v_max3_f32 %0, %1, %2, %3":"=v"(r):"v"(a),"v"(b),"v"(c));return r;}
__device__ __forceinline__ float max2f(float a,float b){float r;asm("v_max_f32_e32 %0, %1, %2":"=v"(r):"v"(a),"v"(b));return r;}
__device__ __forceinline__ float fadd_s(float a,float b){float r;asm("v_add_f32_e32 %0, %1, %2":"=v"(r):"v"(a),"v"(b));return r;}
__device__ __forceinline__ float fsub_s(float a,float b){float r;asm("v_sub_f32_e32 %0, %1, %2":"=v"(r):"v"(a),"v"(b));return r;}
typedef float f32x2_t __attribute__((ext_vector_type(2))); typedef __bf16 bf16x2_t __attribute__((ext_vector_type(2)));
__device__ __forceinline__ unsigned cvtpk_s(float lo,float hi){f32x2_t v={lo,hi};bf16x2_t b=__builtin_convertvector(v,bf16x2_t);return __builtin_bit_cast(unsigned,b);}
#define WAIT_BAR(N) asm volatile("s_waitcnt vmcnt(" #N ") lgkmcnt(0)\n\ts_barrier":::"memory")

__device__ __forceinline__ void qkt(f32x16&p0,f32x16&p1,const char*Kslot,const bf16x8*qr,const f32x16&negm,int r32,int hi){
  const char*kb=Kslot+hi*1024+r32*16;
  #pragma unroll
  for(int d0=0;d0<4;++d0){
    const bf16x8 b0=*reinterpret_cast<const bf16x8*>(kb+d0*2048);
    const bf16x8 b1=*reinterpret_cast<const bf16x8*>(kb+d0*2048+512);
    if(d0==0){p0=__builtin_amdgcn_mfma_f32_32x32x16_bf16(b0,qr[0],negm,0,0,0);p1=__builtin_amdgcn_mfma_f32_32x32x16_bf16(b1,qr[0],negm,0,0,0);}
    else{p0=__builtin_amdgcn_mfma_f32_32x32x16_bf16(b0,qr[d0],p0,0,0,0);p1=__builtin_amdgcn_mfma_f32_32x32x16_bf16(b1,qr[d0],p1,0,0,0);}}
}
typedef __attribute__((address_space(3))) const char* lds_cptr;
typedef short v4i16_t __attribute__((ext_vector_type(4)));
__device__ __forceinline__ void kload8(bf16x8*kf,lds_cptr kp){
  kf[0]=*(const __attribute__((address_space(3))) bf16x8*)(kp);      kf[1]=*(const __attribute__((address_space(3))) bf16x8*)(kp+512);
  kf[2]=*(const __attribute__((address_space(3))) bf16x8*)(kp+2048); kf[3]=*(const __attribute__((address_space(3))) bf16x8*)(kp+2560);
  kf[4]=*(const __attribute__((address_space(3))) bf16x8*)(kp+4096); kf[5]=*(const __attribute__((address_space(3))) bf16x8*)(kp+4608);
  kf[6]=*(const __attribute__((address_space(3))) bf16x8*)(kp+6144); kf[7]=*(const __attribute__((address_space(3))) bf16x8*)(kp+6656);
}
__device__ __forceinline__ void kload2(bf16x8*kf,lds_cptr kp,int j){ kf[2*j]=*(const __attribute__((address_space(3))) bf16x8*)(kp+j*2048); kf[2*j+1]=*(const __attribute__((address_space(3))) bf16x8*)(kp+j*2048+512); }
__device__ __forceinline__ s16x4 vtr(lds_cptr p){ return __builtin_bit_cast(s16x4,__builtin_amdgcn_ds_read_tr16_b64_v4i16((__attribute__((address_space(3))) v4i16_t*)p)); }
__device__ __forceinline__ float rowmax(const f32x16&p0,const f32x16&p1){
  float a=max3f(p0[0],p0[1],p1[0]),b=max3f(p0[2],p0[3],p1[1]);a=max3f(a,p1[2],p1[3]);
  #pragma unroll
  for(int r=4;r<16;r+=4){a=max3f(a,p0[r],p0[r+1]);b=max3f(b,p0[r+2],p0[r+3]);a=max3f(a,p1[r],p1[r+1]);b=max3f(b,p1[r+2],p1[r+3]);}
  const float m=max2f(a,b);
  auto rr=__builtin_amdgcn_permlane32_swap(__float_as_uint(m),__float_as_uint(m),false,false);
  return max2f(__uint_as_float(rr[0]),__uint_as_float(rr[1]));
}
__device__ __forceinline__ void pv(f32x16*o,int vb,bf16x8 pa0,bf16x8 pa1,bf16x8 pa2,bf16x8 pa3){
  #pragma unroll
  for(int d0=0;d0<2;++d0){s16x4 lo[4],hi[4];
    #pragma unroll
    for(int ks=0;ks<4;++ks){
      asm volatile("ds_read_b64_tr_b16 %0,%1 offset:%c2":"=&v"(lo[ks]):"v"(vb),"i"(d0*4096+ks*1024):"memory");
      asm volatile("ds_read_b64_tr_b16 %0,%1 offset:%c2":"=&v"(hi[ks]):"v"(vb),"i"(d0*4096+ks*1024+512):"memory");}
    asm volatile("s_waitcnt lgkmcnt(0)":::"memory");SBAR();
    #define PK(k) (bf16x8){lo[k][0],lo[k][1],lo[k][2],lo[k][3],hi[k][0],hi[k][1],hi[k][2],hi[k][3]}
    o[d0]=__builtin_amdgcn_mfma_f32_32x32x16_bf16(pa0,PK(0),o[d0],0,0,0);
    o[d0]=__builtin_amdgcn_mfma_f32_32x32x16_bf16(pa1,PK(1),o[d0],0,0,0);
    o[d0]=__builtin_amdgcn_mfma_f32_32x32x16_bf16(pa2,PK(2),o[d0],0,0,0);
    o[d0]=__builtin_amdgcn_mfma_f32_32x32x16_bf16(pa3,PK(3),o[d0],0,0,0);
    #undef PK
  }
}

#ifndef ATTN_STORE16
#define ATTN_STORE16(p,v) (*(u32x4*)(p)=(v))
#endif
template<int THRL,bool CAUSAL,bool BIAS,bool FIXED,int KP,int OP> __device__ __forceinline__ void attn_unit(const bf16*Qb,const int QP,const bf16*__restrict__ Kh,const bf16*__restrict__ Vh,bf16*Ob,const int NT_,const float*__restrict__ biasg,const float*__restrict__ biasq,const float bound,char*shm){
  int tid_l=threadIdx.x; asm volatile("":"+v"(tid_l)); const int tid=tid_l,lane=tid&63,r32=lane&31,hi=lane>>5; const int wid=__builtin_amdgcn_readfirstlane(tid>>6);
  const bf16*Qw=Qb+(long)(wid*QBLK)*QP;
  const lds_cptr shm3=(lds_cptr)shm;
  const unsigned lds0=(unsigned)(uintptr_t)shm;
  float*wsf=(float*)(shm+LDS_WS)+wid*64;
  const bf16*ksrc=Kh+(long)lane*KP+wid*8;
  const bf16*vsrc=Vh+(long)(16*(wid&3)+(lane>>2))*KP+(wid>>2)*32+(lane&3)*8;
  const unsigned kdst=lds0+LDS_K+wid*1024, vdst=lds0+LDS_V+wid*1024;
  #define DMA_K(t,slot) glds16(ksrc+(long)(t)*KVBLK*KP,(unsigned)__builtin_amdgcn_readfirstlane(kdst+(slot)))
  #define DMA_V(t,slot) glds16(vsrc+(long)(t)*KVBLK*KP,(unsigned)__builtin_amdgcn_readfirstlane(vdst+(slot)))
  const int vb0=(int)(lds0+LDS_V)+((lane>>4)&1)*32+(lane&3)*8+(4*hi+((lane&15)>>2))*64;
  const char*Kbase=shm+LDS_K; bf16x8 kf[8];
  const lds_cptr kp0=shm3+LDS_K+hi*1024+r32*16; const lds_cptr vp0=shm3+LDS_V+((lane>>4)&1)*32+(lane&3)*8+(4*hi+((lane&15)>>2))*64;
  const int NT=NT_;
  typedef __attribute__((address_space(3))) f32x4v* lds_f4p;
  if(BIAS){ const lds_f4p bl=(lds_f4p)(shm3+LDS_BIAS); const int n4=NT*16; for(int i=tid;i<n4;i+=NW*64){ bl[i]=((const f32x4v*)biasg)[i]; } }
  #define BIASADD(P0,P1,t) do{ if(BIAS){ const __attribute__((address_space(3))) f32x4v* bp_=(const __attribute__((address_space(3))) f32x4v*)(shm3+LDS_BIAS+(hi<<4))+(t)*16; \
    const float sub_=FIXED?refq:mhat; const f32x2_t s2_={sub_,sub_}; \
    _Pragma("unroll") for(int j_=0;j_<4;++j_){ const f32x4v b0_=bp_[2*j_], b1_=bp_[8+2*j_]; \
      const f32x2_t a0_=(f32x2_t){b0_[0],b0_[1]}-s2_, a1_=(f32x2_t){b0_[2],b0_[3]}-s2_, c0_=(f32x2_t){b1_[0],b1_[1]}-s2_, c1_=(f32x2_t){b1_[2],b1_[3]}-s2_; \
      const f32x2_t p0_=(f32x2_t){P0[4*j_],P0[4*j_+1]}+a0_, p1_=(f32x2_t){P0[4*j_+2],P0[4*j_+3]}+a1_, q0_=(f32x2_t){P1[4*j_],P1[4*j_+1]}+c0_, q1_=(f32x2_t){P1[4*j_+2],P1[4*j_+3]}+c1_; \
      P0[4*j_]=p0_[0];P0[4*j_+1]=p0_[1];P0[4*j_+2]=p1_[0];P0[4*j_+3]=p1_[1]; P1[4*j_]=q0_[0];P1[4*j_+1]=q0_[1];P1[4*j_+2]=q1_[0];P1[4*j_+3]=q1_[1]; } } }while(0)
  DMA_K(0,0);DMA_V(0,0);DMA_K(1,SLOTB);
  bf16x8 qr[4];
  #pragma unroll
  for(int d0=0;d0<4;++d0)qr[d0]=*reinterpret_cast<const bf16x8*>(&Qw[(long)r32*QP+d0*16+hi*8]);
  float mhat=0.f,l_reg=0.f;f32x16 o[2];f32x16 negm; { float z0_; asm volatile("v_mov_b32 %0, 0":"=v"(z0_)); _Pragma("unroll") for(int r=0;r<16;++r){o[0][r]=z0_;o[1][r]=z0_;negm[r]=z0_;} } float refq=0.f; if(FIXED){ refq=biasq[wid*QBLK+r32]+bound; } if(!BIAS)asm volatile("":"+v"(negm));
  const int qrel=wid*QBLK+r32;
  #define CMASK(P0,P1,t) do{ if(CAUSAL){int jb_=(t)-(NT-4); if(jb_>=0)cmask(P0,P1,jb_,qrel,hi);} }while(0)
  bool resc=false;
  #define START(P0,P1) do{ resc=false; \
    if(!FIXED){ const float rm=rowmax(P0,P1); const float dl=rm; mhat=fadd_s(mhat,dl); \
      _Pragma("unroll") for(int r=0;r<16;++r){P0[r]=fsub_s(P0[r],dl);P1[r]=fsub_s(P1[r],dl);} \
      if(!BIAS){ _Pragma("unroll") for(int r=0;r<16;++r)negm[r]=-mhat; asm volatile("":"+v"(negm)); } } \
    _Pragma("unroll") for(int r=0;r<16;++r)P0[r]=__builtin_amdgcn_exp2f(P0[r]); }while(0)
  #define RESC() do{ if(!FIXED&&resc){ asm volatile("s_waitcnt lgkmcnt(0)":::"memory"); \
      _Pragma("unroll") for(int d_=0;d_<2;++d_) _Pragma("unroll") for(int r=0;r<16;++r)o[d_][r]*=wsf[crow(r,hi)]; } }while(0)
  f32x16 pA0,pA1,pB0,pB1;
  int sl_prev=0,sl_cur=0,sl_next=SLOTB;
  #define ROT() do{sl_prev=sl_cur;sl_cur=sl_next;sl_next=(sl_next==(NSLOT-1)*SLOTB)?0:sl_next+SLOTB;}while(0)
  DMA_K(2,2*SLOTB);
  WAIT_BAR(3);
  if(BIAS){qkt(pA0,pA1,Kbase,qr,f32x16{},r32,hi);}else{qkt(pA0,pA1,Kbase,qr,negm,r32,hi);}asm volatile("s_nop 15\n\ts_nop 7":"+v"(pA0),"+v"(pA1));BIASADD(pA0,pA1,0);CMASK(pA0,pA1,0);
  START(pA0,pA1);
  _Pragma("unroll") for(int r=0;r<16;++r)pA1[r]=__builtin_amdgcn_exp2f(pA1[r]);
  WAIT_BAR(0);
  DMA_K(3,0);DMA_V(1,SLOTB);
  ROT();
  kload8(kf,kp0+sl_cur);
  WAIT_BAR(2);
  s16x4 vlo[8],vhi[8]; u32x4 pw0,pw1,pw2,pw3;
  #define PKW(P,B) cvtpk_s(P[B],P[B+1])
  #define PAF(k) __builtin_bit_cast(bf16x8,pw##k)
  #define VFR(i) (bf16x8){vlo[i][0],vlo[i][1],vlo[i][2],vlo[i][3],vhi[i][0],vhi[i][1],vhi[i][2],vhi[i][3]}
  #define PIN(x) asm volatile("":"+v"(x))
  #define MX3(a,b,c) __builtin_fmaxf(__builtin_fmaxf((a),(b)),(c))
  #define GAPA(MF,A0,A1,A2,A3,W0,W1,PW) do{ MF; sacc+=A0; sacc+=A1; sacc+=A2; sacc+=A3; PIN(sacc); W0; W1; PIN(PW); SBAR(); }while(0)
  #define EX(v) __builtin_amdgcn_exp2f(v)
  #define GAPB(MF,X,B) do{ MF; X[B]=EX(X[B]); X[B+1]=EX(X[B+1]); X[B+2]=EX(X[B+2]); X[B+3]=EX(X[B+3]); PIN(X); SBAR(); }while(0)
  #define VRD(i) do{ vlo[i]=vtr(vp_+(((i)>>2)*4096+((i)&3)*1024)); vhi[i]=vtr(vp_+(((i)>>2)*4096+((i)&3)*1024+512)); }while(0)
  #define KRD(G,j) do{ if(G){ kload2(kf,kp0+sl_next,j); SBAR(); } }while(0)
  #define STEP(C0,C1,P0,P1,t,GK,GV,GL) do{ SBAR(); \
    const lds_cptr vp_=vp0+sl_prev; \
    VRD(0); SBAR(); float sacc=(P0[0]+P0[1]); \
    GAPA(C0=(BIAS?__builtin_amdgcn_mfma_f32_32x32x16_bf16(kf[0],qr[0],f32x16{},0,0,0):__builtin_amdgcn_mfma_f32_32x32x16_bf16(kf[0],qr[0],negm,0,0,0)), P0[2],P0[3],P0[4],P0[5],     pw0[0]=PKW(P0,0), pw0[1]=PKW(P0,2), pw0); \
    VRD(4); SBAR(); GAPA(C1=(BIAS?__builtin_amdgcn_mfma_f32_32x32x16_bf16(kf[1],qr[0],f32x16{},0,0,0):__builtin_amdgcn_mfma_f32_32x32x16_bf16(kf[1],qr[0],negm,0,0,0)), P0[6],P0[7],P0[8],P0[9],     pw0[2]=PKW(P0,4), pw0[3]=PKW(P0,6), pw0); \
    VRD(1); SBAR(); GAPA(C0=__builtin_amdgcn_mfma_f32_32x32x16_bf16(kf[2],qr[1],C0,0,0,0),   P0[10],P0[11],P0[12],P0[13], pw1[0]=PKW(P0,8), pw1[1]=PKW(P0,10), pw1); \
    VRD(5); SBAR(); GAPA(C1=__builtin_amdgcn_mfma_f32_32x32x16_bf16(kf[3],qr[1],C1,0,0,0),   P0[14],P0[15],P1[0],P1[1],   pw1[2]=PKW(P0,12),pw1[3]=PKW(P0,14), pw1); \
    VRD(2); SBAR(); GAPA(C0=__builtin_amdgcn_mfma_f32_32x32x16_bf16(kf[4],qr[2],C0,0,0,0),   P1[2],P1[3],P1[4],P1[5],     pw2[0]=PKW(P1,0), pw2[1]=PKW(P1,2), pw2); \
    VRD(6); SBAR(); GAPA(C1=__builtin_amdgcn_mfma_f32_32x32x16_bf16(kf[5],qr[2],C1,0,0,0),   P1[6],P1[7],P1[8],P1[9],     pw2[2]=PKW(P1,4), pw2[3]=PKW(P1,6), pw2); \
    VRD(3); SBAR(); GAPA(C0=__builtin_amdgcn_mfma_f32_32x32x16_bf16(kf[6],qr[3],C0,0,0,0),   P1[10],P1[11],P1[12],P1[13], pw3[0]=PKW(P1,8), pw3[1]=PKW(P1,10), pw3); \
    VRD(7); SBAR(); GAPA(C1=__builtin_amdgcn_mfma_f32_32x32x16_bf16(kf[7],qr[3],C1,0,0,0),   P1[14],P1[15],0.f,0.f,       pw3[2]=PKW(P1,12),pw3[3]=PKW(P1,14), pw3); \
    l_reg+=sacc; \
    if(GK){DMA_K((t)+3,sl_cur);} if(GV){DMA_V((t)+1,sl_next);} \
    BIASADD(C0,C1,t); CMASK(C0,C1,t); \
    if(!FIXED){ float a=MX3(C0[0],C0[1],C1[0]),b=MX3(C0[2],C0[3],C1[1]); a=MX3(a,C1[2],C1[3]); \
      _Pragma("unroll") for(int r=4;r<16;r+=4){a=MX3(a,C0[r],C0[r+1]);b=MX3(b,C0[r+2],C0[r+3]);a=MX3(a,C1[r],C1[r+1]);b=MX3(b,C1[r+2],C1[r+3]);} \
      float rm=__builtin_fmaxf(a,b); { auto rr=__builtin_amdgcn_permlane32_swap(__float_as_uint(rm),__float_as_uint(rm),false,false); rm=__builtin_fmaxf(__uint_as_float(rr[0]),__uint_as_float(rr[1])); } \
      resc=false; \
      if(__builtin_expect(__any(rm>(float)THRL),0)){ const float dl=__builtin_fmaxf(rm,0.f); mhat+=dl; \
        _Pragma("unroll") for(int r=0;r<16;++r){C0[r]-=dl;C1[r]-=dl;} \
        if(!BIAS){ _Pragma("unroll") for(int r=0;r<16;++r)negm[r]=-mhat; asm volatile("":"+v"(negm)); } \
        const float f=__builtin_amdgcn_exp2f(-dl); l_reg*=f; if(hi==0)wsf[r32]=f; resc=true; } } \
    SBAR(); \
    GAPB(o[0]=__builtin_amdgcn_mfma_f32_32x32x16_bf16(PAF(0),VFR(0),o[0],0,0,0), C0,0); \
    GAPB(o[1]=__builtin_amdgcn_mfma_f32_32x32x16_bf16(PAF(0),VFR(4),o[1],0,0,0), C0,4); \
    KRD(GL,0); GAPB(o[0]=__builtin_amdgcn_mfma_f32_32x32x16_bf16(PAF(1),VFR(1),o[0],0,0,0), C0,8); \
    KRD(GL,1); GAPB(o[1]=__builtin_amdgcn_mfma_f32_32x32x16_bf16(PAF(1),VFR(5),o[1],0,0,0), C0,12); \
    KRD(GL,2); GAPB(o[0]=__builtin_amdgcn_mfma_f32_32x32x16_bf16(PAF(2),VFR(2),o[0],0,0,0), C1,0); \
    KRD(GL,3); GAPB(o[1]=__builtin_amdgcn_mfma_f32_32x32x16_bf16(PAF(2),VFR(6),o[1],0,0,0), C1,4); \
    GAPB(o[0]=__builtin_amdgcn_mfma_f32_32x32x16_bf16(PAF(3),VFR(3),o[0],0,0,0), C1,8); \
    GAPB(o[1]=__builtin_amdgcn_mfma_f32_32x32x16_bf16(PAF(3),VFR(7),o[1],0,0,0), C1,12); \
    }while(0)
  int t=1;
  #undef CMASK
  #define CMASK(P0,P1,t) do{}while(0)
  for(;t+5<NT;t+=2){
    STEP(pB0,pB1,pA0,pA1,t,true,true,true);     WAIT_BAR(2); RESC(); ROT();
    STEP(pA0,pA1,pB0,pB1,t+1,true,true,true);   WAIT_BAR(2); RESC(); ROT();
  }
  #undef CMASK
  #define CMASK(P0,P1,t) do{ if(CAUSAL){int jb_=(t)-(NT-4); if(jb_>=0)cmask(P0,P1,jb_,qrel,hi);} }while(0)
  #define ENDW(tt) do{ if((tt)+3<NT){WAIT_BAR(2);} else if((tt)+2<NT){WAIT_BAR(1);} else {WAIT_BAR(0);} }while(0)
  for(;t+1<NT;t+=2){
    STEP(pB0,pB1,pA0,pA1,t,(t+3<NT),(t+1<NT),(t+1<NT));       ENDW(t);   RESC(); ROT();
    STEP(pA0,pA1,pB0,pB1,t+1,(t+4<NT),(t+2<NT),(t+2<NT));     ENDW(t+1); RESC(); ROT();
  }
  STEP(pB0,pB1,pA0,pA1,NT-1,false,false,false); RESC();
  { float sacc=pB0[0]+pB0[1]; _Pragma("unroll") for(int r=2;r<16;++r)sacc+=pB0[r]; _Pragma("unroll") for(int r=0;r<16;++r)sacc+=pB1[r]; l_reg+=sacc;
    pw0=(u32x4){PKW(pB0,0),PKW(pB0,2),PKW(pB0,4),PKW(pB0,6)};pw1=(u32x4){PKW(pB0,8),PKW(pB0,10),PKW(pB0,12),PKW(pB0,14)};pw2=(u32x4){PKW(pB1,0),PKW(pB1,2),PKW(pB1,4),PKW(pB1,6)};pw3=(u32x4){PKW(pB1,8),PKW(pB1,10),PKW(pB1,12),PKW(pB1,14)};
    SBAR(); pv(o,vb0+sl_cur,PAF(0),PAF(1),PAF(2),PAF(3)); }
  #undef PKW
  #undef PAF
  #undef VFR
  #undef PIN
  #undef MX3
  #undef GAPA
  #undef GAPB
  #undef EX
  #undef VRD
  #undef KRD
  #undef STEP
  #undef ENDW
  int tid_e=threadIdx.x; asm volatile("":"+v"(tid_e)); const int lane_e=tid_e&63,r32_e=lane_e&31,hi_e=lane_e>>5; float*wsf_e=(float*)(shm+LDS_WS)+wid*64;
  {auto rr=__builtin_amdgcn_permlane32_swap(__float_as_uint(l_reg),__float_as_uint(l_reg),false,false);l_reg=__uint_as_float(rr[0])+__uint_as_float(rr[1]);}
  if(hi_e==0)wsf_e[32+r32_e]=l_reg;asm volatile("s_waitcnt lgkmcnt(0)":::"memory");
  float rli[16];
  #pragma unroll
  for(int r=0;r<16;++r)rli[r]=__builtin_amdgcn_rcpf(wsf_e[32+crow(r,hi_e)]);
  bf16*Ow=Ob+(long)(wid*QBLK)*OP;
  { bf16*stg=(bf16*)(shm+LDS_OST)+wid*2048;
    #pragma unroll
    for(int r=0;r<16;++r){const int orow=crow(r,hi_e);
      #pragma unroll
      for(int d0=0;d0<2;++d0)stg[orow*64+d0*32+r32_e]=__float2bfloat16(o[d0][r]*rli[r]);}
    asm volatile("s_waitcnt lgkmcnt(0)":::"memory");
    #pragma unroll
    for(int i=0;i<4;++i){const int row=i*8+(lane_e>>3),ch=lane_e&7; const u32x4 v=*(const u32x4*)(stg+row*64+ch*8); ATTN_STORE16(Ow+(long)row*OP+ch*8,v);} }
  asm volatile("s_waitcnt lgkmcnt(0)\n\ts_barrier":::"memory");
  #undef DMA_K
  #undef DMA_V
  #undef CMASK
  #undef BIASADD
  #undef START
  #undef RESC
  #undef ROT
}
constexpr int ATTN_LDS_BYTES=LDS_BYTES;
#undef SBAR
#undef WAIT_BAR
}
#define GAS __attribute__((address_space(1)))
#define LAS __attribute__((address_space(3)))
typedef unsigned short bf16;
typedef unsigned v4u __attribute__((ext_vector_type(4)));
typedef unsigned v2u __attribute__((ext_vector_type(2)));
typedef float f32x4 __attribute__((ext_vector_type(4)));
typedef short bf16x8 __attribute__((ext_vector_type(8)));
typedef float f32x16 __attribute__((ext_vector_type(16)));
#define LDS_WAIT() asm volatile("s_waitcnt lgkmcnt(0)" ::: "memory")

constexpr int NWAVES = 8;
constexpr int M = 32768, DM = 1024, FF = 2816, SEQ = 8192, NBATCH = 4, MEML = 256;
constexpr int NFOX = 2560, NFOX_SRC = 2572, NGM = 1792;
constexpr float EPS = 1e-6f;
constexpr size_t MiB = 1u << 20;
constexpr size_t WS_WFI = 1 * MiB;
constexpr size_t WS_WFO = 45 * MiB;
constexpr size_t WS_WFOX = 67 * MiB;
constexpr size_t WS_WGM = 72 * MiB;
constexpr size_t WS_WOUT = 76 * MiB;
constexpr size_t WS_WMKV = 80 * MiB;
constexpr size_t WS_WSB = 82 * MiB;
constexpr size_t WS_MEMN = 83 * MiB;
constexpr size_t WS_KVM = 85 * MiB;
constexpr size_t WS_LOGF = 87 * MiB;
constexpr size_t WS_BIAS = 89 * MiB;
constexpr size_t WS_SSQ = 91 * MiB;
constexpr size_t WS_XN = 96 * MiB;
constexpr size_t WS_CAT = 160 * MiB;
constexpr size_t WS_G = 224 * MiB;
constexpr size_t WS_END = 400 * MiB;
constexpr int LDS_BYTES = 132096;

__device__ __forceinline__ unsigned f2bf(float f) { unsigned u = __builtin_bit_cast(unsigned, f); return (u + 0x7fffu + ((u >> 16) & 1u)) >> 16; }
__device__ __forceinline__ unsigned pk2(float lo, float hi) { return f2bf(lo) | (f2bf(hi) << 16); }
__device__ __forceinline__ float bf2f(unsigned short b) { return __builtin_bit_cast(float, (unsigned)b << 16); }
__device__ __forceinline__ float wave_sum(float v) {
#pragma unroll
    for (int o = 1; o < 64; o <<= 1) v += __shfl_xor(v, o);
    return v;
}

__device__ __forceinline__ void conv_item(const float* W, int K, int Nsrc, int sc0, bf16* WTrow0, int k0, LAS float* scr, int lane, const float* gain = nullptr) {
    {
        f32x4 w[8]; const int c4 = lane & 7;
#pragma unroll
        for (int i = 0; i < 8; ++i) w[i] = *(const f32x4*)(W + (size_t)(k0 + 8 * i + (lane >> 3)) * Nsrc + sc0 + 4 * c4);
#pragma unroll
        for (int i = 0; i < 8; ++i) { const int kk = 8 * i + (lane >> 3); const float gk = gain ? gain[k0 + kk] : 1.0f; LAS float* d = scr + kk * 33 + 4 * c4;
            d[0] = w[i].x * gk; d[1] = w[i].y * gk; d[2] = w[i].z * gk; d[3] = w[i].w * gk; }
    }
    LDS_WAIT(); asm volatile("" ::: "memory");
    const int c = lane & 7;
#pragma unroll
    for (int j = 0; j < 4; ++j) { const int n = (lane >> 3) + 8 * j; const LAS float* s = scr + (8 * c) * 33 + n;
        v4u o; o.x = pk2(s[0 * 33], s[1 * 33]); o.y = pk2(s[2 * 33], s[3 * 33]); o.z = pk2(s[4 * 33], s[5 * 33]); o.w = pk2(s[6 * 33], s[7 * 33]);
        *(v4u*)(WTrow0 + (size_t)n * K + k0 + 8 * c) = o; }
    LDS_WAIT(); asm volatile("" ::: "memory");
}
__device__ __forceinline__ int map_plain(int n0) { return n0; }
__device__ __forceinline__ int map_swiglu(int n0) { const int t = n0 >> 8, j = n0 & 255; return (j < 128) ? 128 * t + j : FF + 128 * t + (j - 128); }
__device__ __forceinline__ int map_head(int n0, int gap_tile, int gap) { const int t = n0 >> 8, p = n0 & 255, bj = p >> 7, wc = (p >> 5) & 3; return 256 * t + 64 * wc + 32 * bj + (t >= gap_tile ? gap : 0); }

struct Args { const float* in[22]; float* out; unsigned char* ws; };

__device__ __forceinline__ void norm_row(const float* xrow, const f32x4 (&gn)[4], bf16* orow, int lane, f32x4 (&v)[4]) {
    const f32x4* xr = (const f32x4*)xrow + lane; float s = 0.f;
#pragma unroll
    for (int j = 0; j < 4; ++j) { v[j] = xr[64 * j]; s += (v[j].x * v[j].x + v[j].y * v[j].y) + (v[j].z * v[j].z + v[j].w * v[j].w); }
    const float rstd = 1.0f / sqrtf(wave_sum(s) * (1.f / DM) + EPS);
    unsigned long long* o8 = (unsigned long long*)orow + lane;
#pragma unroll
    for (int j = 0; j < 4; ++j) { v[j] = v[j] * rstd * gn[j]; o8[64 * j] = (unsigned long long)pk2(v[j].x, v[j].y) | ((unsigned long long)pk2(v[j].z, v[j].w) << 32); }
}

__device__ __forceinline__ void gmlp_unit(int rc, int g, const bf16* PROJ, const bf16* WSB, const float* bs, bf16* CAT, LAS unsigned char* lds, int tid_in) {
    int tid = tid_in; asm volatile("" : "+v"(tid));
    const int lane = tid & 63, wid = tid >> 6, r32 = lane & 31, hi = lane >> 5;
    LAS bf16* VT = (LAS bf16*)lds;
    {
        const int row = tid >> 2, seg = tid & 3;
        const bf16* src = PROJ + (size_t)(rc * 128 + row) * NGM + 768 + g * 64 + seg * 16;
        const bf16x8 a = *(const bf16x8*)src, b = *(const bf16x8*)(src + 8);
#pragma unroll
        for (int e = 0; e < 8; ++e) { VT[(seg * 16 + e) * 136 + row] = (bf16)a[e]; VT[(seg * 16 + 8 + e) * 136 + row] = (bf16)b[e]; }
    }
    __syncthreads();
    const int tb = wid & 3, db = wid >> 2;
    f32x16 acc; { float z0_; asm volatile("v_mov_b32 %0, 0" : "=v"(z0_));
#pragma unroll
      for (int r = 0; r < 16; ++r) acc[r] = z0_; }
    const bf16* wrow = WSB + ((size_t)g * 128 + tb * 32 + r32) * 128 + 8 * hi;
    const LAS bf16* vrow = VT + (db * 32 + r32) * 136 + 8 * hi;
    const int nks = 2 * (tb + 1);
    for (int ks = 0; ks < nks; ++ks) {
        const bf16x8 A = *(const LAS bf16x8*)(vrow + 16 * ks); const bf16x8 Bf = *(const bf16x8*)(wrow + 16 * ks);
        acc = __builtin_amdgcn_mfma_f32_32x32x16_bf16(A, Bf, acc, 0, 0, 0);
    }
    const int t = tb * 32 + r32; const float bsv = bs[g * 128 + t];
    const size_t row = (size_t)rc * 128 + t;
    const bf16* up = PROJ + row * NGM + g * 64 + db * 32 + 4 * hi;
    bf16* op = CAT + row * DM + g * 64 + db * 32 + 4 * hi;
#pragma unroll
    for (int q = 0; q < 4; ++q) {
        const v2u uv = *(const v2u*)(up + 8 * q);
        const float u0 = __builtin_bit_cast(float, uv.x << 16), u1 = __builtin_bit_cast(float, uv.x & 0xffff0000u), u2 = __builtin_bit_cast(float, uv.y << 16), u3 = __builtin_bit_cast(float, uv.y & 0xffff0000u);
        v2u o; o.x = pk2(u0 * (acc[4 * q] + bsv), u1 * (acc[4 * q + 1] + bsv)); o.y = pk2(u2 * (acc[4 * q + 2] + bsv), u3 * (acc[4 * q + 3] + bsv));
        *(v2u*)(op + 8 * q) = o;
    }
    __syncthreads();
}

__device__ __forceinline__ void grid_bar(unsigned* ctr, unsigned target) {
    asm volatile("s_waitcnt vmcnt(0)" ::: "memory");
    __syncthreads();
    int t = threadIdx.x; asm volatile("" : "+v"(t));
    if (t == 0) {
        __builtin_amdgcn_fence(__ATOMIC_RELEASE, "agent");
        asm volatile("s_waitcnt vmcnt(0)" ::: "memory");
        __hip_atomic_fetch_add(ctr, 1u, __ATOMIC_RELAXED, __HIP_MEMORY_SCOPE_AGENT);
        while (__hip_atomic_load(ctr, __ATOMIC_RELAXED, __HIP_MEMORY_SCOPE_AGENT) < target) __builtin_amdgcn_s_sleep(2);
        __builtin_amdgcn_fence(__ATOMIC_ACQUIRE, "agent");
        asm volatile("s_waitcnt vmcnt(0)" ::: "memory");
    }
    __syncthreads();
}
__global__ void __launch_bounds__(NWAVES * 64, 2) fwd_megakernel(Args args) {
    extern __shared__ __attribute__((aligned(16))) unsigned char lds[];
    cg::grid_group grid = cg::this_grid();
    LAS unsigned char* ldsl = (LAS unsigned char*)lds;
    const int tid = threadIdx.x, lane = tid & 63, wave = __builtin_amdgcn_readfirstlane(tid >> 6);
    const int G = gridDim.x, bx = blockIdx.x;
    const int vcu = (G % 8 == 0) ? (bx % 8) * (G / 8) + bx / 8 : bx;
    const int gw = vcu * NWAVES + wave, NGW = G * NWAVES;
    unsigned char* ws = args.ws;
    const float* x_in = args.in[0]; float* xres = args.out;
#define WFI ((bf16*)(wsl() + WS_WFI))
#define WFO ((bf16*)(wsl() + WS_WFO))
#define WFOX ((bf16*)(wsl() + WS_WFOX))
#define WGM ((bf16*)(wsl() + WS_WGM))
#define WOUT ((bf16*)(wsl() + WS_WOUT))
#define WMKV ((bf16*)(wsl() + WS_WMKV))
#define WSB ((bf16*)(wsl() + WS_WSB))
#define MEMN ((bf16*)(wsl() + WS_MEMN))
#define KVM ((bf16*)(wsl() + WS_KVM))
#define LOGF ((float*)(wsl() + WS_LOGF))
#define BIASA ((float*)(wsl() + WS_BIAS))
#define XN ((bf16*)(wsl() + WS_XN))
#define SSQ ((float*)(wsl() + WS_SSQ))
#define CAT ((bf16*)(wsl() + WS_CAT))
#define GB ((bf16*)(wsl() + WS_G))
    auto wsl = [&]() __attribute__((always_inline)) { unsigned char* p = ws; asm volatile("" : "+s"(p)); return p; };

    {
        LAS float* scr = (LAS float*)(ldsl + wave * 16384);
        constexpr int I_FI = 16 * 176, I_FO = 44 * 32, I_FOX = 16 * 80, I_GM = 16 * 56, I_WO = 16 * 32, I_KV = 16 * 16;
        constexpr int NITEMS = 4 * I_FI + 4 * I_FO + I_FOX + I_GM + 2 * I_WO + 2 * I_KV;
        for (int it = gw; it < NITEMS; it += NGW) {
            int r = it;
            if (r < 4 * I_FI) { const int mi = r / I_FI; r -= mi * I_FI; const int layer = mi >> 1, which = mi & 1; const int kb = r / 176, nb = r % 176;
                const float* W = args.in[which ? 7 : 3] + (size_t)layer * DM * 2 * FF;
                conv_item(W, DM, 2 * FF, map_swiglu(32 * nb), WFI + (size_t)mi * 5632 * DM + (size_t)(32 * nb) * DM, 64 * kb, scr, lane, args.in[which ? 6 : 2] + layer * DM); continue; }
            r -= 4 * I_FI;
            if (r < 4 * I_FO) { const int mi = r / I_FO; r -= mi * I_FO; const int layer = mi >> 1, which = mi & 1; const int kb = r / 32, nb = r % 32;
                const float* W = args.in[which ? 8 : 4] + (size_t)layer * FF * DM;
                conv_item(W, FF, DM, map_plain(32 * nb), WFO + (size_t)mi * DM * FF + (size_t)(32 * nb) * FF, 64 * kb, scr, lane); continue; }
            r -= 4 * I_FO;
            if (r < I_FOX) { const int kb = r / 80, nb = r % 80;
                conv_item(args.in[14], DM, NFOX_SRC, map_head(32 * nb, 9, 12), WFOX + (size_t)(32 * nb) * DM, 64 * kb, scr, lane, args.in[5]); continue; }
            r -= I_FOX;
            if (r < I_GM) { const int kb = r / 56, nb = r % 56;
                conv_item(args.in[18], DM, NGM, map_head(32 * nb, 99, 0), WGM + (size_t)(32 * nb) * DM, 64 * kb, scr, lane, args.in[5] + DM); continue; }
            r -= I_GM;
            if (r < 2 * I_WO) { const int mi = r / I_WO; r -= mi * I_WO; const int kb = r / 32, nb = r % 32;
                conv_item(args.in[9] + (size_t)mi * DM * DM, DM, DM, map_plain(32 * nb), WOUT + (size_t)mi * DM * DM + (size_t)(32 * nb) * DM, 64 * kb, scr, lane); continue; }
            r -= 2 * I_WO;
            { const int mi = r / I_KV; r -= mi * I_KV; const int kb = r / 16, nb = r % 16;
                conv_item(args.in[11] + (size_t)mi * DM * 512, DM, 512, map_head(32 * nb, 99, 0), WMKV + (size_t)mi * 512 * DM + (size_t)(32 * nb) * DM, 64 * kb, scr, lane); }
        }
        if (bx == 0 && tid == 0) { *(unsigned*)wsl() = 0u; *((unsigned*)wsl() + 64) = 0u; }
        for (int i = bx * (NWAVES * 64) + tid; i < 12 * 128 * 128; i += G * NWAVES * 64) { const int s = i & 127, t = (i >> 7) & 127; WSB[i] = (s <= t) ? (bf16)f2bf(args.in[20][i]) : (bf16)0; }
        { f32x4 gn[4], v[4];
#pragma unroll
          for (int j = 0; j < 4; ++j) gn[j] = ((const f32x4*)args.in[10])[lane + 64 * j];
          for (int m = gw; m < NBATCH * MEML; m += NGW) norm_row(args.in[1] + (size_t)m * DM, gn, MEMN + (size_t)m * DM, lane, v); }
        for (int m = gw; m < M; m += NGW) {
            const f32x4* xr = (const f32x4*)(args.in[0] + (size_t)m * DM) + lane; unsigned long long* o8 = (unsigned long long*)(XN + (size_t)m * DM) + lane; float ss = 0.f;
#pragma unroll
            for (int j = 0; j < 4; ++j) { const f32x4 v = xr[64 * j]; ss += (v.x * v.x + v.y * v.y) + (v.z * v.z + v.w * v.w); o8[64 * j] = (unsigned long long)pk2(v.x, v.y) | ((unsigned long long)pk2(v.z, v.w) << 32); }
            ss = wave_sum(ss); if (lane == 0) SSQ[m] = ss;
        }
        for (int i = bx * (NWAVES * 64) + tid; i < 5 * M; i += G * NWAVES * 64) SSQ[M + i] = 0.f;
        __syncthreads();
    }

    grid.sync();
    unsigned nbar = 0;
#define GBAR() do { ++nbar; grid_bar((unsigned*)wsl() + 64, nbar * (unsigned)G); } while (0)
#pragma nounroll
    for (int half = 0; half < 4; ++half) {
        const int layer = half >> 1, which = half & 1;
        int tid = threadIdx.x; asm volatile("" : "+v"(tid)); const int lane = tid & 63;
        const float* xin = (half == 0) ? x_in : xres;
        { pg8::Gemm g{XN, WFI + (size_t)half * 5632 * DM, M, 2 * FF, DM}; pg8::StaticOrder S; S.init(M, 2 * FF, G, bx);
          pg8::EpiSwiGLU E{GB, FF, SSQ + (size_t)(layer * 3 + (which ? 2 : 0)) * M};
          pg8::gemm_phase<pg8::EpiSwiGLU, pg8::StaticOrder, true, true>(ldsl, g, S, E); }
        GBAR();
        { pg8::Gemm g{GB, WFO + (size_t)half * DM * FF, M, DM, FF}; pg8::StaticOrder S; S.init(M, DM, G, bx);
          if (half == 3) { pg8::EpiRes<false> E{xin, xres, nullptr, nullptr, 0.5f}; pg8::gemm_phase<pg8::EpiRes<false>, pg8::StaticOrder, true, true>(ldsl, g, S, E); break; }
          pg8::EpiRes<true> E{xin, xres, XN, SSQ + (size_t)(layer * 3 + (which ? 3 : 1)) * M, 0.5f};
          pg8::gemm_phase<pg8::EpiRes<true>, pg8::StaticOrder, true, true>(ldsl, g, S, E); }
        GBAR();
        if (which == 1) continue;
        const float* ssq_mix = SSQ + (size_t)(layer * 3 + 1) * M;
        if (layer == 0) {
#pragma nounroll
            for (int l2 = 0; l2 < 2; ++l2) {
                pg8::Gemm g{MEMN, WMKV + (size_t)l2 * 512 * DM, NBATCH * MEML, 512, DM}; pg8::StaticOrder S; S.init(NBATCH * MEML, 512, G, (bx + G - 8 * l2) % G);
                pg8::EpiProj<2> E{KVM + (size_t)l2 * 1024 * 512, 512, nullptr, args.in[13] + l2 * 64, nullptr, nullptr};
                pg8::gemm_phase<pg8::EpiProj<2>, pg8::StaticOrder, true, true>(ldsl, g, S, E);
                __syncthreads();
            }
            {
                LAS float* FWT = (LAS float*)ldsl;
                for (int i = tid; i < 12 * DM; i += NWAVES * 64) { const int h = i % 12, k = i / 12; FWT[h * DM + k] = args.in[14][(size_t)k * NFOX_SRC + 2304 + h] * args.in[5][k]; }
                __syncthreads();
                const float bfl = (lane < 12) ? args.in[15][lane] : 0.f;
                int gwl = gw; asm volatile("" : "+s"(gwl));
                for (int m = gwl; m < M; m += NGW) {
                    const v4u xa = *((const v4u*)(XN + (size_t)m * DM) + lane), xc = *((const v4u*)(XN + (size_t)m * DM + 512) + lane);
                    float xv[16];
#pragma unroll
                    for (int e = 0; e < 4; ++e) { xv[2 * e] = __builtin_bit_cast(float, xa[e] << 16); xv[2 * e + 1] = __builtin_bit_cast(float, xa[e] & 0xffff0000u);
                                                  xv[8 + 2 * e] = __builtin_bit_cast(float, xc[e] << 16); xv[8 + 2 * e + 1] = __builtin_bit_cast(float, xc[e] & 0xffff0000u); }
                    float fl = 0.f;
#pragma unroll
                    for (int h = 0; h < 12; ++h) {
                        const LAS f32x4* wp = (const LAS f32x4*)(FWT + h * DM + 8 * lane);
                        const f32x4 w0 = wp[0], w1 = wp[1], w2 = wp[128], w3 = wp[129];
                        float p = ((xv[0] * w0.x + xv[1] * w0.y) + (xv[2] * w0.z + xv[3] * w0.w)) + ((xv[4] * w1.x + xv[5] * w1.y) + (xv[6] * w1.z + xv[7] * w1.w))
                                + ((xv[8] * w2.x + xv[9] * w2.y) + (xv[10] * w2.z + xv[11] * w2.w)) + ((xv[12] * w3.x + xv[13] * w3.y) + (xv[14] * w3.z + xv[15] * w3.w));
                        p = wave_sum(p); if (lane == h) fl = p;
                    }
                    if (lane < 12) { const float rs = 1.0f / sqrtf(ssq_mix[m] * (1.0f / 1024.0f) + EPS); const float f = fl * rs + bfl;
                        const float lf = fminf(f, 0.f) - 0.6931471805599453f * __builtin_amdgcn_logf(1.0f + __builtin_amdgcn_exp2f(-1.4426950408889634f * fabsf(f)));
                        LOGF[(size_t)((m >> 13) * 12 + lane) * SEQ + (m & (SEQ - 1))] = lf; }
                }
                __syncthreads();
            }
            { pg8::Gemm g{XN, WFOX, M, NFOX, DM}; pg8::StaticOrder S; S.init(M, NFOX, G, bx);
              pg8::EpiProj<0> E{GB, NFOX, args.in[16], args.in[17], args.in[12], ssq_mix};
              pg8::gemm_phase<pg8::EpiProj<0>, pg8::StaticOrder, true, true>(ldsl, g, S, E); }
            GBAR();
            if (bx < 48) {
                LAS double* sw = (LAS double*)ldsl;
                const f32x4* lf4 = (const f32x4*)(LOGF + (size_t)bx * SEQ) + tid * 4;
                double loc[16]; double run = 0.0;
#pragma unroll
                for (int j = 0; j < 4; ++j) { const f32x4 q = lf4[j]; run += (double)q.x; loc[4 * j] = run; run += (double)q.y; loc[4 * j + 1] = run; run += (double)q.z; loc[4 * j + 2] = run; run += (double)q.w; loc[4 * j + 3] = run; }
                double sc = run;
#pragma unroll
                for (int o = 1; o < 64; o <<= 1) { const double y = __shfl_up(sc, o); if (lane >= o) sc += y; }
                if (lane == 63) sw[wave] = sc;
                __syncthreads();
                double woff = 0.0;
                for (int w2 = 0; w2 < wave; ++w2) woff += sw[w2];
                const double excl = sc - run + woff;
                f32x4* bo = (f32x4*)(BIASA + (size_t)bx * SEQ) + tid * 4;
#pragma unroll
                for (int j = 0; j < 4; ++j) { f32x4 o; o.x = (float)(-(excl + loc[4 * j]) * 1.4426950408889634); o.y = (float)(-(excl + loc[4 * j + 1]) * 1.4426950408889634);
                    o.z = (float)(-(excl + loc[4 * j + 2]) * 1.4426950408889634); o.w = (float)(-(excl + loc[4 * j + 3]) * 1.4426950408889634); bo[j] = o; }
                __syncthreads();
            }
        } else {
            pg8::Gemm g{XN, WGM, M, NGM, DM}; pg8::StaticOrder S; S.init(M, NGM, G, bx);
            pg8::EpiProj<1> E{GB, NGM, nullptr, args.in[19], args.in[12] + 64, ssq_mix};
            pg8::gemm_phase<pg8::EpiProj<1>, pg8::StaticOrder, true, true>(ldsl, g, S, E);
        }
        GBAR();
        if (layer == 0) {
            const attn_body::bf16* P = (const attn_body::bf16*)GB; attn_body::bf16* C = (attn_body::bf16*)CAT;
            float mq = fabsf(args.in[16][lane]), mk = fabsf(args.in[17][lane]);
#pragma unroll
            for (int o = 1; o < 64; o <<= 1) { mq = fmaxf(mq, __shfl_xor(mq, o)); mk = fmaxf(mk, __shfl_xor(mk, o)); }
            const float bound = __builtin_bit_cast(float, __builtin_amdgcn_readfirstlane(__builtin_bit_cast(int, 64.f * pg8::ATT_C2 * mq * mk * 1.02f + 0.25f)));
            const bool fixed_ok = bound <= 60.f;
            unsigned* qctr = (unsigned*)wsl();
            LAS int* qslot = (LAS int*)(ldsl + 131072);
            for (;;) {
                int tidq = threadIdx.x; asm volatile("" : "+v"(tidq)); const int laneq = tidq & 63;
                if (tidq == 0) *qslot = (int)atomicAdd(qctr, 1u);
                __syncthreads();
                const int idx = __builtin_amdgcn_readfirstlane(*qslot);
                if (idx >= 1536 + 512) break;
                if (idx >= 1536) {
                    const int u = idx - 1536, bm = u >> 5, qb = u & 31, b = bm >> 2, mh = bm & 3; const size_t rowq = (size_t)b * SEQ + qb * 256;
                    const attn_body::bf16* KV = (const attn_body::bf16*)KVM;
                    attn_body::attn_unit<8, false, false, false, 512, DM>(P + rowq * NFOX + 2304 + mh * 64, NFOX, KV + (size_t)(b * MEML) * 512 + mh * 64, KV + (size_t)(b * MEML) * 512 + 256 + mh * 64,
                                                                      C + rowq * DM + 768 + mh * 64, 4, nullptr, nullptr, 0.f, (char*)lds);
                    continue;
                }
                const int qb = 31 - idx / 48, bh = idx % 48, b = bh / 12, h = bh % 12;
                const size_t rowq = (size_t)b * SEQ + qb * 256;
                const float* bb = BIASA + (size_t)bh * SEQ;
                const int NT = 4 * qb + 4;
                if (fixed_ok) {
                    const float bq0 = bb[qb * 256];
                    const int t1 = laneq, t2 = laneq + 64;
                    const bool n1 = (t1 < NT) && (2.f * bound + bb[64 * (t1 < NT ? t1 : 0) + 63] - bq0 >= -48.f);
                    const bool n2 = (t2 < NT) && (2.f * bound + bb[64 * (t2 < NT ? t2 : 0) + 63] - bq0 >= -48.f);
                    const unsigned long long m1 = __ballot(n1), m2 = __ballot(n2);
                    int first = m1 ? (__ffsll((long long)m1) - 1) : (m2 ? 64 + (__ffsll((long long)m2) - 1) : NT);
                    int T0 = first & ~1; if (T0 > NT - 4) T0 = NT - 4;
                    T0 = __builtin_amdgcn_readfirstlane(T0);
                    const size_t rowk = (size_t)b * SEQ + (size_t)T0 * 64;
                    attn_body::attn_unit<8, true, true, true, NFOX, DM>(P + rowq * NFOX + h * 64, NFOX, P + rowk * NFOX + 768 + h * 64, P + rowk * NFOX + 1536 + h * 64,
                                                                    C + rowq * DM + h * 64, NT - T0, bb + T0 * 64, bb + qb * 256, bound, (char*)lds);
                } else {
                    const size_t rowk = (size_t)b * SEQ;
                    attn_body::attn_unit<8, true, true, false, NFOX, DM>(P + rowq * NFOX + h * 64, NFOX, P + rowk * NFOX + 768 + h * 64, P + rowk * NFOX + 1536 + h * 64,
                                                                     C + rowq * DM + h * 64, NT, bb, nullptr, 0.f, (char*)lds);
                }
            }
        } else {
            for (int u = vcu; u < 256 * 12; u += G) gmlp_unit(u / 12, u % 12, GB, WSB, args.in[21], CAT, ldsl, tid);
        }
        if (layer == 1) {
            const int QP = layer == 0 ? NFOX : NGM; const int mqc = layer == 0 ? 2304 : 1536;
            const attn_body::bf16* P = (const attn_body::bf16*)GB; attn_body::bf16* C = (attn_body::bf16*)CAT; const attn_body::bf16* KV = (const attn_body::bf16*)(KVM + (size_t)layer * 1024 * 512);
            for (int u = vcu; u < 512; u += G) {
                const int bm = u >> 5, qb = u & 31, b = bm >> 2, mh = bm & 3; const size_t rowq = (size_t)b * SEQ + qb * 256;
                attn_body::attn_unit<8, false, false, false, 512, DM>(P + rowq * QP + mqc + mh * 64, QP, KV + (size_t)(b * MEML) * 512 + mh * 64, KV + (size_t)(b * MEML) * 512 + 256 + mh * 64,
                                                           C + rowq * DM + 768 + mh * 64, 4, nullptr, nullptr, 0.f, (char*)lds);
            }
        }
        GBAR();
        { pg8::Gemm g{CAT, WOUT + (size_t)layer * DM * DM, M, DM, DM}; pg8::StaticOrder S; S.init(M, DM, G, bx);
          pg8::EpiRes<true> E{xres, xres, XN, SSQ + (size_t)(layer * 3 + 2) * M, 1.0f};
          pg8::gemm_phase<pg8::EpiRes<true>, pg8::StaticOrder, true, true>(ldsl, g, S, E); }
        GBAR();
    }
}

extern "C" void kernel_launch(void* const* d_in, const int* in_sizes, int n_in, void* d_out, int out_size, void* d_ws, size_t ws_size, hipStream_t stream) {
    static int grid_blocks = 0;
    if (grid_blocks == 0) {
        if (n_in != 22 || out_size != M * DM || ws_size < WS_END) { fprintf(stderr, "kernel_launch: unexpected problem (n_in %d, out %d, ws %zu)\n", n_in, out_size, ws_size); grid_blocks = -1; return; }
        int dev = 0, cus = 0, per_cu = 0;
        hipGetDevice(&dev);
        hipDeviceGetAttribute(&cus, hipDeviceAttributeMultiprocessorCount, dev);
        if (hipFuncSetAttribute((const void*)fwd_megakernel, hipFuncAttributeMaxDynamicSharedMemorySize, LDS_BYTES) != hipSuccess) { fprintf(stderr, "kernel_launch: hipFuncSetAttribute failed\n"); grid_blocks = -1; return; }
        if (hipOccupancyMaxActiveBlocksPerMultiprocessor(&per_cu, (const void*)fwd_megakernel, NWAVES * 64, LDS_BYTES) != hipSuccess || per_cu < 1) { fprintf(stderr, "kernel_launch: occupancy query gave %d\n", per_cu); per_cu = 1; }
        (void)hipGetLastError();
        grid_blocks = cus * per_cu;
        if (grid_blocks > 256) grid_blocks = 256;
    }
    if (grid_blocks < 0) return;
    Args a{};
    for (int i = 0; i < 22; ++i) a.in[i] = (const float*)d_in[i];
    a.out = (float*)d_out; a.ws = (unsigned char*)d_ws;
    void* kargs[] = {&a};
    hipError_t e = hipLaunchCooperativeKernel((const void*)fwd_megakernel, dim3(grid_blocks), dim3(NWAVES * 64), kargs, LDS_BYTES, stream);
    if (e != hipSuccess) fprintf(stderr, "cooperative launch failed: %s (grid %d)\n", hipGetErrorString(e), grid_blocks);
}
```

```cpp
#include <hip/hip_runtime.h>
#include <hip/hip_cooperative_groups.h>
#include <hip/hip_bf16.h>
#include <cstdio>
#include <cstdint>
#include <cmath>
namespace cg = cooperative_groups;
namespace pg8 {
#define PG8_LAS __attribute__((address_space(3)))
typedef unsigned short bf16_t;
typedef short bf16x8 __attribute__((ext_vector_type(8)));
typedef float f32x4 __attribute__((ext_vector_type(4)));
typedef unsigned u32x4 __attribute__((ext_vector_type(4)));
constexpr int BM = 256, BK = 64, HALF = 128, HTB = HALF * BK * 2  , STAGE_BYTES = 8 * HTB, NXCD = 8, WGM = 8;

__host__ __device__ __forceinline__ int lds_byte(int r, int c) { const int st = (r >> 4) * 2 + (c >> 5), rr = r & 15, cc = c & 31, ob = rr * 64 + cc * 2; return st * 1024 + (ob ^ (((ob >> 9) & 1) << 5)); }
__host__ __device__ __forceinline__ void stage_rc(int b, int& R, int& C) { const int st = b / 1024, sb = b % 1024, swz = sb ^ (((sb >> 9) & 1) << 5); R = (st >> 1) * 16 + swz / 64; C = (st & 1) * 32 + (swz % 64) / 2; }
__host__ __device__ __forceinline__ int perm32(int rho) { const int n = rho >> 4, i = rho & 15; return 8 * (i >> 2) + 4 * n + (i & 3); }

struct Unit { int pm, pn; };
struct Gemm { const bf16_t* A; const bf16_t* Bt; int M, N, K; };

struct StaticOrder {
    int nM, nN, nwg, G, c;
    __host__ __device__ void init(int M, int N, int G_, int c_) { nM = M / BM; nN = N / BM; nwg = nM * nN; G = G_; c = c_; }
    __host__ __device__ bool next(int i, Unit& u) const {
        const long L = (long)i * G + c; if (L >= nwg) return false;
        int wgid = (int)L; { const int q = nwg / NXCD, r = nwg % NXCD, xcd = wgid % NXCD, off = wgid / NXCD; wgid = (xcd < r ? xcd * (q + 1) : r * (q + 1) + (xcd - r) * q) + off; }
        const int nig = WGM * nN, gid = wgid / nig, fm = gid * WGM, gsz = (nM - fm) < WGM ? (nM - fm) : WGM;
        u.pm = fm + ((wgid % nig) % gsz); u.pn = (wgid % nig) / gsz; return true;
    }
    __device__ __forceinline__ void a_ready(const Unit&) const {}
    __device__ __forceinline__ void done(const Unit&) const {}
};
__device__ __forceinline__ unsigned cvt_pk_bf16(float lo, float hi) { unsigned r; asm volatile("v_cvt_pk_bf16_f32 %0, %1, %2" : "=v"(r) : "v"(lo), "v"(hi)); return r; }
typedef float f32x2 __attribute__((ext_vector_type(2)));
typedef unsigned u32x2 __attribute__((ext_vector_type(2)));
__device__ __forceinline__ float mul_sigmoid(float v, float z) { return v * __builtin_amdgcn_rcpf(1.0f + __builtin_amdgcn_exp2f(-1.4426950408889634f * z)); }
__device__ __forceinline__ float gelu_tanh(float v) { return mul_sigmoid(v, 1.5957691216057308f * (v + 0.044715f * v * v * v)); }
constexpr float ATT_C2 = 0.125f * 1.4426950408889634f;

struct EpiSwiGLU {
    static constexpr bool PERM = true, AFTER_DRAIN = false;
    bf16_t* O; int ldc; const float* ssq;
    __device__ __forceinline__ void operator()(const f32x4 (&acc)[2][2][4][2], const Unit& u, int wr, int wc, int fr, int fq) const {
        const int row0 = u.pm * BM + wr * 64 + fr; const int col0 = u.pn * 128 + wc * 32 + 8 * fq;
#pragma unroll
        for (int ai = 0; ai < 2; ++ai)
#pragma unroll
            for (int m = 0; m < 4; ++m) {
                bf16_t* p = O + (size_t)(row0 + ai * HALF + m * 16) * ldc + col0;
                const float rs = __builtin_amdgcn_rsqf(ssq[row0 + ai * HALF + m * 16] * (1.0f / 1024.0f) + 1e-6f);
                const f32x4 a0 = acc[ai][0][m][0] * rs, a1 = acc[ai][0][m][1] * rs, b0 = acc[ai][1][m][0] * rs, b1 = acc[ai][1][m][1] * rs;
                u32x4 w;
                w.x = cvt_pk_bf16(mul_sigmoid(a0[0], a0[0]) * b0[0], mul_sigmoid(a0[1], a0[1]) * b0[1]);
                w.y = cvt_pk_bf16(mul_sigmoid(a0[2], a0[2]) * b0[2], mul_sigmoid(a0[3], a0[3]) * b0[3]);
                w.z = cvt_pk_bf16(mul_sigmoid(a1[0], a1[0]) * b1[0], mul_sigmoid(a1[1], a1[1]) * b1[1]);
                w.w = cvt_pk_bf16(mul_sigmoid(a1[2], a1[2]) * b1[2], mul_sigmoid(a1[3], a1[3]) * b1[3]);
                *(u32x4*)p = w;
            }
    }
};
template <bool WXB> struct EpiRes {
    static constexpr bool PERM = true, AFTER_DRAIN = false;
    const float* xin; float* xout; bf16_t* xb; float* ssq; float s;
    __device__ __forceinline__ void operator()(const f32x4 (&acc)[2][2][4][2], const Unit& u, int wr, int wc, int fr, int fq) const {
        const int row0 = u.pm * BM + wr * 64 + fr; const int col0 = u.pn * BM + wc * 32 + 8 * fq;
#pragma unroll
        for (int ai = 0; ai < 2; ++ai)
#pragma unroll
            for (int m = 0; m < 4; ++m) {
                const int row = row0 + ai * HALF + m * 16; const size_t off = (size_t)row * 1024 + col0; float ss = 0.f;
#pragma unroll
                for (int bj = 0; bj < 2; ++bj) {
                    const f32x4 o0 = *(const f32x4*)(xin + off + bj * HALF) + acc[ai][bj][m][0] * s, o1 = *(const f32x4*)(xin + off + bj * HALF + 4) + acc[ai][bj][m][1] * s;
                    *(f32x4*)(xout + off + bj * HALF) = o0; *(f32x4*)(xout + off + bj * HALF + 4) = o1;
                    if (WXB) { u32x4 w; w.x = cvt_pk_bf16(o0[0], o0[1]); w.y = cvt_pk_bf16(o0[2], o0[3]); w.z = cvt_pk_bf16(o1[0], o1[1]); w.w = cvt_pk_bf16(o1[2], o1[3]); *(u32x4*)(xb + off + bj * HALF) = w;
                        ss += ((o0[0] * o0[0] + o0[1] * o0[1]) + (o0[2] * o0[2] + o0[3] * o0[3])) + ((o1[0] * o1[0] + o1[1] * o1[1]) + (o1[2] * o1[2] + o1[3] * o1[3])); }
                }
                if (WXB) { ss += __shfl_xor(ss, 16); ss += __shfl_xor(ss, 32); if (fq == 0) unsafeAtomicAdd(ssq + row, ss); }
            }
    }
};
template <int KIND> struct EpiProj {
    static constexpr bool PERM = true, AFTER_DRAIN = false;
    bf16_t* O; int ldc; const float* gq; const float* gk; const float* gm; const float* ssq;
    __device__ __forceinline__ void operator()(const f32x4 (&acc)[2][2][4][2], const Unit& u, int wr, int wc, int fr, int fq) const {
        int mode = 0; const float* g = gk; float sc = 1.f; const int pn = u.pn;
        if (KIND == 0) { if (pn < 3) { mode = 1; g = gq; sc = ATT_C2; } else if (pn < 6) { mode = 1; g = gk; } else if (pn < 9) { mode = 0; } else { mode = 1; g = gm; sc = ATT_C2; } }
        else if (KIND == 1) { if (pn < 3) { mode = 2; } else if (pn < 6) { mode = 3; g = gk + (4 * (pn - 3) + wc) * 64; } else { mode = 1; g = gm; sc = ATT_C2; } }
        else { if (pn == 0) { mode = 1; g = gk; } else { mode = 0; } }
        f32x4 gv[2][2];
#pragma unroll
        for (int bj = 0; bj < 2; ++bj)
#pragma unroll
            for (int n = 0; n < 2; ++n) gv[bj][n] = (mode & 1) ? *(const f32x4*)(g + 32 * bj + 8 * fq + 4 * n) * sc : (f32x4){1.f, 1.f, 1.f, 1.f};
        const int row0 = u.pm * BM + wr * 64 + fr; const int col0 = pn * BM + wc * 64 + 8 * fq;
#pragma unroll
        for (int ai = 0; ai < 2; ++ai)
#pragma unroll
            for (int m = 0; m < 4; ++m) {
                f32x4 v[2][2];
#pragma unroll
                for (int bj = 0; bj < 2; ++bj)
#pragma unroll
                    for (int n = 0; n < 2; ++n) v[bj][n] = acc[ai][bj][m][n];
                if (KIND != 2) { const float rs = __builtin_amdgcn_rsqf(ssq[row0 + ai * HALF + m * 16] * (1.0f / 1024.0f) + 1e-6f);
#pragma unroll
                    for (int bj = 0; bj < 2; ++bj)
#pragma unroll
                        for (int n = 0; n < 2; ++n) v[bj][n] = v[bj][n] * rs; }
                if (mode & 2) {
#pragma unroll
                    for (int bj = 0; bj < 2; ++bj)
#pragma unroll
                        for (int n = 0; n < 2; ++n)
#pragma unroll
                            for (int e = 0; e < 4; ++e) v[bj][n][e] = gelu_tanh(v[bj][n][e]);
                }
                if (mode & 1) {
                    float ss = 0.f;
#pragma unroll
                    for (int bj = 0; bj < 2; ++bj)
#pragma unroll
                        for (int n = 0; n < 2; ++n) { const f32x4 x = v[bj][n]; ss += (x[0] * x[0] + x[1] * x[1]) + (x[2] * x[2] + x[3] * x[3]); }
                    ss += __shfl_xor(ss, 16); ss += __shfl_xor(ss, 32);
                    const float r = __builtin_amdgcn_rsqf(ss * (1.0f / 64.0f) + 1e-6f);
#pragma unroll
                    for (int bj = 0; bj < 2; ++bj)
#pragma unroll
                        for (int n = 0; n < 2; ++n) v[bj][n] = v[bj][n] * r * gv[bj][n];
                }
                bf16_t* p = O + (size_t)(row0 + ai * HALF + m * 16) * ldc + col0;
#pragma unroll
                for (int bj = 0; bj < 2; ++bj) {
                    u32x4 w; w.x = cvt_pk_bf16(v[bj][0][0], v[bj][0][1]); w.y = cvt_pk_bf16(v[bj][0][2], v[bj][0][3]); w.z = cvt_pk_bf16(v[bj][1][0], v[bj][1][1]); w.w = cvt_pk_bf16(v[bj][1][2], v[bj][1][3]);
                    *(u32x4*)(p + 32 * bj) = w;
                }
            }
    }
};
template <class Epi, class Sched, bool ALIGN_EPI = false, bool SP2 = false>
__device__ __forceinline__ void gemm_phase(PG8_LAS unsigned char* lds, const Gemm g, const Sched& S, const Epi& E) {
    int tid_l = threadIdx.x; asm volatile("" : "+v"(tid_l));
    const int tid = tid_l, wid = __builtin_amdgcn_readfirstlane(tid >> 6), lane = tid & 63, wr = wid >> 2, wc = wid & 3, fr = lane & 15, fq = lane >> 4;
    const int K = g.K, nt = K / BK;
    unsigned voffA[2], voffB[2];
#pragma unroll
    for (int i = 0; i < 2; ++i) { int R, C; stage_rc(tid * 16 + i * 8192, R, C); const int Rb = Epi::PERM ? ((R & ~31) + perm32(R & 31)) : R;
        voffA[i] = (unsigned)(R * K + C) * 2u; voffB[i] = (unsigned)(Rb * K + C) * 2u; }
    const size_t kstep = (size_t)(BK * 2);
    const size_t hstep = (size_t)HALF * K * 2;
    const size_t tstep = 2 * hstep;
    const unsigned ldsw = (unsigned)wid * 1024u;
    const int aoff = lds_byte(wr * 64 + fr, fq * 8), boff = lds_byte(wc * 32 + fr, fq * 8);
#define PG8_SA(b, h) (((b) * 2 + (h)) * HTB)
#define PG8_SB(b, h) ((4 + (b) * 2 + (h)) * HTB)
#define PG8_STAGE(bufoff, gbase, voff) do { _Pragma("unroll") for (int _i = 0; _i < 2; ++_i) \
        __builtin_amdgcn_global_load_lds((const unsigned*)((const char*)(gbase) + (voff)[_i]), (PG8_LAS unsigned*)(lds + (bufoff) + ldsw + _i * 8192), 16, 0, 0); } while (0)
#define PG8_LDA(dst, b, h) do { _Pragma("unroll") for (int m = 0; m < 4; ++m) _Pragma("unroll") for (int k = 0; k < 2; ++k) dst[m][k] = *(const PG8_LAS bf16x8*)(lds + PG8_SA(b, h) + aoff + m * 2048 + k * 1024); } while (0)
#define PG8_LDB(dst, b, h) do { _Pragma("unroll") for (int n = 0; n < 2; ++n) _Pragma("unroll") for (int k = 0; k < 2; ++k) dst[n][k] = *(const PG8_LAS bf16x8*)(lds + PG8_SB(b, h) + boff + n * 2048 + k * 1024); } while (0)
#define PG8_MMA(ai, bj, At, Bt) do { __builtin_amdgcn_s_setprio(1); _Pragma("unroll") for (int m = 0; m < 4; ++m) _Pragma("unroll") for (int n = 0; n < 2; ++n) _Pragma("unroll") for (int k = 0; k < 2; ++k) \
        acc[ai][bj][m][n] = __builtin_amdgcn_mfma_f32_16x16x32_bf16(Bt[n][k], At[m][k], acc[ai][bj][m][n], 0, 0, 0); __builtin_amdgcn_s_setprio(0); } while (0)
#define PG8_WAIT_V(n) asm volatile("s_waitcnt vmcnt(" #n ")" ::: "memory")
#define PG8_WAIT_L(n) asm volatile("s_waitcnt lgkmcnt(" #n ")" ::: "memory")
#define PG8_BAR __builtin_amdgcn_s_barrier()
#define PG8_SCHED __builtin_amdgcn_sched_barrier(0)
    Unit cur, nxt; int ui = 0;
    if (!S.next(0, cur)) return;
    f32x4 acc[2][2][4][2];
#pragma unroll
    for (int a = 0; a < 2; ++a)
#pragma unroll
        for (int b = 0; b < 2; ++b)
#pragma unroll
            for (int m = 0; m < 4; ++m)
#pragma unroll
                for (int n = 0; n < 2; ++n) acc[a][b][m][n] = (f32x4){0.f, 0.f, 0.f, 0.f};
    bf16x8 At[4][2], B0[2][2], B1[2][2];
    const char* cA = (const char*)g.A + (size_t)cur.pm * tstep; const char* cB = (const char*)g.Bt + (size_t)cur.pn * tstep;
    S.a_ready(cur);
    if constexpr (SP2) {
        PG8_STAGE(PG8_SB(0, 0), cB, voffB); PG8_STAGE(PG8_SB(0, 1), cB + hstep, voffB); PG8_STAGE(PG8_SA(0, 0), cA, voffA); PG8_STAGE(PG8_SA(0, 1), cA + hstep, voffA);
        if (wr == 1) PG8_BAR;
        PG8_WAIT_V(2); PG8_BAR;
        PG8_STAGE(PG8_SB(1, 0), cB + kstep, voffB); PG8_STAGE(PG8_SA(1, 0), cA + kstep, voffA); PG8_STAGE(PG8_SB(1, 1), cB + hstep + kstep, voffB);
        PG8_WAIT_V(6); PG8_BAR;
    } else {
        PG8_STAGE(PG8_SB(0, 0), cB, voffB); PG8_STAGE(PG8_SA(0, 0), cA, voffA); PG8_STAGE(PG8_SB(0, 1), cB + hstep, voffB); PG8_STAGE(PG8_SA(0, 1), cA + hstep, voffA);
        if (wr == 1) PG8_BAR;
        PG8_WAIT_V(4); PG8_BAR;
        PG8_STAGE(PG8_SB(1, 0), cB + kstep, voffB); PG8_STAGE(PG8_SA(1, 0), cA + kstep, voffA); PG8_STAGE(PG8_SB(1, 1), cB + hstep + kstep, voffB);
        PG8_WAIT_V(6); PG8_BAR;
    }
    for (;;) {
        const bool has_next = S.next(ui + 1, nxt);
        const char* nA = has_next ? (const char*)g.A + (size_t)nxt.pm * tstep : cA; const char* nB = has_next ? (const char*)g.Bt + (size_t)nxt.pn * tstep : cB;
        for (int t = 0; t < nt; t += 2) {
            const bool last = (t == nt - 2);
            const char* a1 = cA + (size_t)(t + 1) * kstep;
            const char* a2 = last ? nA : cA + (size_t)(t + 2) * kstep; const char* b2 = last ? nB : cB + (size_t)(t + 2) * kstep;
            const char* a3 = a2 + kstep; const char* b3 = b2 + kstep;
            if (last && has_next) S.a_ready(nxt);
            if constexpr (SP2) {
            PG8_LDB(B0, 0, 0); PG8_LDB(B1, 0, 1); PG8_SCHED; PG8_LDA(At, 0, 0); PG8_STAGE(PG8_SA(1, 1), a1 + hstep, voffA);
            PG8_WAIT_V(8); PG8_WAIT_L(0); PG8_BAR; PG8_MMA(0, 0, At, B0); PG8_MMA(0, 1, At, B1); PG8_BAR; PG8_SCHED;
            PG8_LDA(At, 0, 1); PG8_STAGE(PG8_SB(0, 0), b2, voffB); PG8_STAGE(PG8_SB(0, 1), b2 + hstep, voffB); PG8_STAGE(PG8_SA(0, 0), a2, voffA);
            PG8_WAIT_V(8); PG8_WAIT_L(0); PG8_BAR; PG8_MMA(1, 0, At, B0); PG8_MMA(1, 1, At, B1); PG8_BAR; PG8_SCHED;
            PG8_LDB(B0, 1, 0); PG8_LDB(B1, 1, 1); PG8_SCHED; PG8_LDA(At, 1, 0); PG8_STAGE(PG8_SA(0, 1), a2 + hstep, voffA);
            PG8_WAIT_V(8); PG8_WAIT_L(0); PG8_BAR; PG8_MMA(0, 0, At, B0); PG8_MMA(0, 1, At, B1); PG8_BAR; PG8_SCHED;
            PG8_LDA(At, 1, 1); PG8_STAGE(PG8_SB(1, 0), b3, voffB); PG8_STAGE(PG8_SB(1, 1), b3 + hstep, voffB); PG8_STAGE(PG8_SA(1, 0), a3, voffA);
            PG8_WAIT_V(8); PG8_WAIT_L(0); PG8_BAR; PG8_MMA(1, 0, At, B0); PG8_MMA(1, 1, At, B1); PG8_BAR; PG8_SCHED;
            } else {
            PG8_LDB(B0, 0, 0); PG8_SCHED; PG8_LDA(At, 0, 0); PG8_STAGE(PG8_SA(1, 1), a1 + hstep, voffA);
            PG8_WAIT_L(8); PG8_BAR; PG8_WAIT_L(0); PG8_MMA(0, 0, At, B0); PG8_BAR; PG8_SCHED;
            PG8_LDB(B1, 0, 1); PG8_STAGE(PG8_SB(0, 0), b2, voffB);
            PG8_BAR; PG8_WAIT_L(0); PG8_MMA(0, 1, At, B1); PG8_BAR;
            PG8_LDA(At, 0, 1); PG8_STAGE(PG8_SA(0, 0), a2, voffA);
            PG8_BAR; PG8_WAIT_L(0); PG8_MMA(1, 0, At, B0); PG8_BAR; PG8_SCHED;
            PG8_STAGE(PG8_SB(0, 1), b2 + hstep, voffB);
            PG8_WAIT_V(6); PG8_BAR; PG8_MMA(1, 1, At, B1); PG8_BAR;
            PG8_LDB(B0, 1, 0); PG8_SCHED; PG8_LDA(At, 1, 0); PG8_STAGE(PG8_SA(0, 1), a2 + hstep, voffA);
            PG8_WAIT_L(8); PG8_BAR; PG8_WAIT_L(0); PG8_MMA(0, 0, At, B0); PG8_BAR; PG8_SCHED;
            PG8_LDB(B1, 1, 1); PG8_STAGE(PG8_SB(1, 0), b3, voffB);
            PG8_BAR; PG8_WAIT_L(0); PG8_MMA(0, 1, At, B1); PG8_BAR;
            PG8_LDA(At, 1, 1); PG8_STAGE(PG8_SA(1, 0), a3, voffA);
            PG8_BAR; PG8_WAIT_L(0); PG8_MMA(1, 0, At, B0); PG8_BAR; PG8_SCHED;
            PG8_STAGE(PG8_SB(1, 1), b3 + hstep, voffB);
            PG8_WAIT_V(6); PG8_BAR; PG8_MMA(1, 1, At, B1); PG8_BAR;
            }
        }
        if constexpr (ALIGN_EPI) { if (wr == 0) PG8_BAR; }
        if constexpr (!Epi::AFTER_DRAIN) { E(acc, cur, wr, wc, fr, fq); S.done(cur); }
        if (!has_next) break;
#pragma unroll
        for (int a = 0; a < 2; ++a)
#pragma unroll
            for (int b = 0; b < 2; ++b)
#pragma unroll
                for (int m = 0; m < 4; ++m)
#pragma unroll
                    for (int n = 0; n < 2; ++n) acc[a][b][m][n] = (f32x4){0.f, 0.f, 0.f, 0.f};
        cur = nxt; cA = nA; cB = nB; ++ui;
        if constexpr (ALIGN_EPI) { if (wr == 1) PG8_BAR; }
    }
    PG8_WAIT_V(0);
    if constexpr (!ALIGN_EPI) { if (wr == 0) PG8_BAR; }
    PG8_BAR;
    if constexpr (Epi::AFTER_DRAIN) { E.fused(acc, cur, wr, wc, fr, fq, lds, wid, lane); S.done(cur); }
#undef PG8_SA
#undef PG8_SB
#undef PG8_STAGE
#undef PG8_LDA
#undef PG8_LDB
#undef PG8_MMA
#undef PG8_WAIT_V
#undef PG8_WAIT_L
#undef PG8_BAR
#undef PG8_SCHED
}
}
#include <hip/hip_bf16.h>
#include <cmath>
namespace attn_body {
using bf16=__hip_bfloat16;
using bf16x8=__attribute__((ext_vector_type(8)))short;
using s16x4=__attribute__((ext_vector_type(4)))short;
using f32x16=__attribute__((ext_vector_type(16)))float;
using u32x4=__attribute__((ext_vector_type(4)))unsigned;
using f32x4v=__attribute__((ext_vector_type(4)))float;
constexpr int D=64;
constexpr int NW=8,QBLK=32,QB=QBLK*NW,KVBLK=64;
__device__ __forceinline__ int crow(int r,int hi){return (r&3)+8*(r>>2)+4*hi;}
#define SBAR() __builtin_amdgcn_sched_barrier(0)
__device__ __forceinline__ void cmask(f32x16&p0,f32x16&p1,int jb,int qrel,int hi){
  const float NEG=-INFINITY; int kb=64*jb+4*hi;
  #pragma unroll
  for(int r=0;r<16;++r){int kv=kb+(r&3)+8*(r>>2); if(kv>qrel)p0[r]=NEG; if(kv+32>qrel)p1[r]=NEG;}
}

constexpr int NSLOT=3, SLOTB=8192;
constexpr int LDS_K=0, LDS_V=NSLOT*SLOTB, LDS_WS=2*NSLOT*SLOTB, LDS_OST=LDS_WS+NW*64*4, LDS_BIAS=LDS_OST+NW*4096, LDS_BYTES=LDS_BIAS+32768;
constexpr float C2=0.125f*1.4426950408889634f;
__device__ __forceinline__ void glds16(const void*gsrc,unsigned lds_dst){unsigned keep;
  asm volatile("s_mov_b32 %0, m0\n\ts_mov_b32 m0, %2\n\ts_nop 0\n\tglobal_load_lds_dwordx4 %1, off\n\ts_mov_b32 m0, %0":"=&s"(keep):"v"(gsrc),"s"(lds_dst):"memory");}
__device__ __forceinline__ float max3f(float a,float b,float c){float r;asm("v_max3_f32 %0, %1, %2, %3":"=v"(r):"v"(a),"v"(b),"v"(c));return r;}
__device__ __forceinline__ float max2f(float a,float b){float r;asm("v_max_f32_e32 %0, %1, %2":"=v"(r):"v"(a),"v"(b));return r;}
__device__ __forceinline__ float fadd_s(float a,float b){float r;asm("v_add_f32_e32 %0, %1, %2":"=v"(r):"v"(a),"v"(b));return r;}
__device__ __forceinline__ float fsub_s(float a,float b){float r;asm("v_sub_f32_e32 %0, %1, %2":"=v"(r):"v"(a),"v"(b));return r;}
typedef float f32x2_t __attribute__((ext_vector_type(2))); typedef __bf16 bf16x2_t __attribute__((ext_vector_type(2)));
__device__ __forceinline__ unsigned cvtpk_s(float lo,float hi){f32x2_t v={lo,hi};bf16x2_t b=__builtin_convertvector(v,bf16x2_t);return __builtin_bit_cast(unsigned,b);}
#define WAIT_BAR(N) asm volatile("s_waitcnt vmcnt(" #N ") lgkmcnt(0)\n\ts_barrier":::"memory")

__device__ __forceinline__ void qkt(f32x16&p0,f32x16&p1,const char*Kslot,const bf16x8*qr,const f32x16&negm,int r32,int hi){
  const char*kb=Kslot+hi*1024+r32*16;
  #pragma unroll
  for(int d0=0;d0<4;++d0){
    const bf16x8 b0=*reinterpret_cast<const bf16x8*>(kb+d0*2048);
    const bf16x8 b1=*reinterpret_cast<const bf16x8*>(kb+d0*2048+512);
    if(d0==0){p0=__builtin_amdgcn_mfma_f32_32x32x16_bf16(b0,qr[0],negm,0,0,0);p1=__builtin_amdgcn_mfma_f32_32x32x16_bf16(b1,qr[0],negm,0,0,0);}
    else{p0=__builtin_amdgcn_mfma_f32_32x32x16_bf16(b0,qr[d0],p0,0,0,0);p1=__builtin_amdgcn_mfma_f32_32x32x16_bf16(b1,qr[d0],p1,0,0,0);}}
}
typedef __attribute__((address_space(3))) const char* lds_cptr;
typedef short v4i16_t __attribute__((ext_vector_type(4)));
__device__ __forceinline__ void kload8(bf16x8*kf,lds_cptr kp){
  kf[0]=*(const __attribute__((address_space(3))) bf16x8*)(kp);      kf[1]=*(const __attribute__((address_space(3))) bf16x8*)(kp+512);
  kf[2]=*(const __attribute__((address_space(3))) bf16x8*)(kp+2048); kf[3]=*(const __attribute__((address_space(3))) bf16x8*)(kp+2560);
  kf[4]=*(const __attribute__((address_space(3))) bf16x8*)(kp+4096); kf[5]=*(const __attribute__((address_space(3))) bf16x8*)(kp+4608);
  kf[6]=*(const __attribute__((address_space(3))) bf16x8*)(kp+6144); kf[7]=*(const __attribute__((address_space(3))) bf16x8*)(kp+6656);
}
__device__ __forceinline__ void kload2(bf16x8*kf,lds_cptr kp,int j){ kf[2*j]=*(const __attribute__((address_space(3))) bf16x8*)(kp+j*2048); kf[2*j+1]=*(const __attribute__((address_space(3))) bf16x8*)(kp+j*2048+512); }
__device__ __forceinline__ s16x4 vtr(lds_cptr p){ return __builtin_bit_cast(s16x4,__builtin_amdgcn_ds_read_tr16_b64_v4i16((__attribute__((address_space(3))) v4i16_t*)p)); }
__device__ __forceinline__ float rowmax(const f32x16&p0,const f32x16&p1){
  float a=max3f(p0[0],p0[1],p1[0]),b=max3f(p0[2],p0[3],p1[1]);a=max3f(a,p1[2],p1[3]);
  #pragma unroll
  for(int r=4;r<16;r+=4){a=max3f(a,p0[r],p0[r+1]);b=max3f(b,p0[r+2],p0[r+3]);a=max3f(a,p1[r],p1[r+1]);b=max3f(b,p1[r+2],p1[r+3]);}
  const float m=max2f(a,b);
  auto rr=__builtin_amdgcn_permlane32_swap(__float_as_uint(m),__float_as_uint(m),false,false);
  return max2f(__uint_as_float(rr[0]),__uint_as_float(rr[1]));
}
__device__ __forceinline__ void pv(f32x16*o,int vb,bf16x8 pa0,bf16x8 pa1,bf16x8 pa2,bf16x8 pa3){
  #pragma unroll
  for(int d0=0;d0<2;++d0){s16x4 lo[4],hi[4];
    #pragma unroll
    for(int ks=0;ks<4;++ks){
      asm volatile("ds_read_b64_tr_b16 %0,%1 offset:%c2":"=&v"(lo[ks]):"v"(vb),"i"(d0*4096+ks*1024):"memory");
      asm volatile("ds_read_b64_tr_b16 %0,%1 offset:%c2":"=&v"(hi[ks]):"v"(vb),"i"(d0*4096+ks*1024+512):"memory");}
    asm volatile("s_waitcnt lgkmcnt(0)":::"memory");SBAR();
    #define PK(k) (bf16x8){lo[k][0],lo[k][1],lo[k][2],lo[k][3],hi[k][0],hi[k][1],hi[k][2],hi[k][3]}
    o[d0]=__builtin_amdgcn_mfma_f32_32x32x16_bf16(pa0,PK(0),o[d0],0,0,0);
    o[d0]=__builtin_amdgcn_mfma_f32_32x32x16_bf16(pa1,PK(1),o[d0],0,0,0);
    o[d0]=__builtin_amdgcn_mfma_f32_32x32x16_bf16(pa2,PK(2),o[d0],0,0,0);
    o[d0]=__builtin_amdgcn_mfma_f32_32x32x16_bf16(pa3,PK(3),o[d0],0,0,0);
    #undef PK
  }
}

#ifndef ATTN_STORE16
#define ATTN_STORE16(p,v) (*(u32x4*)(p)=(v))
#endif
template<int THRL,bool CAUSAL,bool BIAS,bool FIXED,int KP,int OP> __device__ __forceinline__ void attn_unit(const bf16*Qb,const int QP,const bf16*__restrict__ Kh,const bf16*__restrict__ Vh,bf16*Ob,const int NT_,const float*__restrict__ biasg,const float*__restrict__ biasq,const float bound,char*shm){
  int tid_l=threadIdx.x; asm volatile("":"+v"(tid_l)); const int tid=tid_l,lane=tid&63,r32=lane&31,hi=lane>>5; const int wid=__builtin_amdgcn_readfirstlane(tid>>6);
  const bf16*Qw=Qb+(long)(wid*QBLK)*QP;
  const lds_cptr shm3=(lds_cptr)shm;
  const unsigned lds0=(unsigned)(uintptr_t)shm;
  float*wsf=(float*)(shm+LDS_WS)+wid*64;
  const bf16*ksrc=Kh+(long)lane*KP+wid*8;
  const bf16*vsrc=Vh+(long)(16*(wid&3)+(lane>>2))*KP+(wid>>2)*32+(lane&3)*8;
  const unsigned kdst=lds0+LDS_K+wid*1024, vdst=lds0+LDS_V+wid*1024;
  #define DMA_K(t,slot) glds16(ksrc+(long)(t)*KVBLK*KP,(unsigned)__builtin_amdgcn_readfirstlane(kdst+(slot)))
  #define DMA_V(t,slot) glds16(vsrc+(long)(t)*KVBLK*KP,(unsigned)__builtin_amdgcn_readfirstlane(vdst+(slot)))
  const int vb0=(int)(lds0+LDS_V)+((lane>>4)&1)*32+(lane&3)*8+(4*hi+((lane&15)>>2))*64;
  const char*Kbase=shm+LDS_K; bf16x8 kf[8];
  const lds_cptr kp0=shm3+LDS_K+hi*1024+r32*16; const lds_cptr vp0=shm3+LDS_V+((lane>>4)&1)*32+(lane&3)*8+(4*hi+((lane&15)>>2))*64;
  const int NT=NT_;
  typedef __attribute__((address_space(3))) f32x4v* lds_f4p;
  if(BIAS){ const lds_f4p bl=(lds_f4p)(shm3+LDS_BIAS); const int n4=NT*16; for(int i=tid;i<n4;i+=NW*64){ bl[i]=((const f32x4v*)biasg)[i]; } }
  #define BIASADD(P0,P1,t) do{ if(BIAS){ const __attribute__((address_space(3))) f32x4v* bp_=(const __attribute__((address_space(3))) f32x4v*)(shm3+LDS_BIAS+(hi<<4))+(t)*16; \
    const float sub_=FIXED?refq:mhat; const f32x2_t s2_={sub_,sub_}; \
    _Pragma("unroll") for(int j_=0;j_<4;++j_){ const f32x4v b0_=bp_[2*j_], b1_=bp_[8+2*j_]; \
      const f32x2_t a0_=(f32x2_t){b0_[0],b0_[1]}-s2_, a1_=(f32x2_t){b0_[2],b0_[3]}-s2_, c0_=(f32x2_t){b1_[0],b1_[1]}-s2_, c1_=(f32x2_t){b1_[2],b1_[3]}-s2_; \
      const f32x2_t p0_=(f32x2_t){P0[4*j_],P0[4*j_+1]}+a0_, p1_=(f32x2_t){P0[4*j_+2],P0[4*j_+3]}+a1_, q0_=(f32x2_t){P1[4*j_],P1[4*j_+1]}+c0_, q1_=(f32x2_t){P1[4*j_+2],P1[4*j_+3]}+c1_; \
      P0[4*j_]=p0_[0];P0[4*j_+1]=p0_[1];P0[4*j_+2]=p1_[0];P0[4*j_+3]=p1_[1]; P1[4*j_]=q0_[0];P1[4*j_+1]=q0_[1];P1[4*j_+2]=q1_[0];P1[4*j_+3]=q1_[1]; } } }while(0)
  DMA_K(0,0);DMA_V(0,0);DMA_K(1,SLOTB);
  bf16x8 qr[4];
  #pragma unroll
  for(int d0=0;d0<4;++d0)qr[d0]=*reinterpret_cast<const bf16x8*>(&Qw[(long)r32*QP+d0*16+hi*8]);
  float mhat=0.f,l_reg=0.f;f32x16 o[2];f32x16 negm; { float z0_; asm volatile("v_mov_b32 %0, 0":"=v"(z0_)); _Pragma("unroll") for(int r=0;r<16;++r){o[0][r]=z0_;o[1][r]=z0_;negm[r]=z0_;} } float refq=0.f; if(FIXED){ refq=biasq[wid*QBLK+r32]+bound; } if(!BIAS)asm volatile("":"+v"(negm));
  const int qrel=wid*QBLK+r32;
  #define CMASK(P0,P1,t) do{ if(CAUSAL){int jb_=(t)-(NT-4); if(jb_>=0)cmask(P0,P1,jb_,qrel,hi);} }while(0)
  bool resc=false;
  #define START(P0,P1) do{ resc=false; \
    if(!FIXED){ const float rm=rowmax(P0,P1); const float dl=rm; mhat=fadd_s(mhat,dl); \
      _Pragma("unroll") for(int r=0;r<16;++r){P0[r]=fsub_s(P0[r],dl);P1[r]=fsub_s(P1[r],dl);} \
      if(!BIAS){ _Pragma("unroll") for(int r=0;r<16;++r)negm[r]=-mhat; asm volatile("":"+v"(negm)); } } \
    _Pragma("unroll") for(int r=0;r<16;++r)P0[r]=__builtin_amdgcn_exp2f(P0[r]); }while(0)
  #define RESC() do{ if(!FIXED&&resc){ asm volatile("s_waitcnt lgkmcnt(0)":::"memory"); \
      _Pragma("unroll") for(int d_=0;d_<2;++d_) _Pragma("unroll") for(int r=0;r<16;++r)o[d_][r]*=wsf[crow(r,hi)]; } }while(0)
  f32x16 pA0,pA1,pB0,pB1;
  int sl_prev=0,sl_cur=0,sl_next=SLOTB;
  #define ROT() do{sl_prev=sl_cur;sl_cur=sl_next;sl_next=(sl_next==(NSLOT-1)*SLOTB)?0:sl_next+SLOTB;}while(0)
  DMA_K(2,2*SLOTB);
  WAIT_BAR(3);
  if(BIAS){qkt(pA0,pA1,Kbase,qr,f32x16{},r32,hi);}else{qkt(pA0,pA1,Kbase,qr,negm,r32,hi);}asm volatile("s_nop 15\n\ts_nop 7":"+v"(pA0),"+v"(pA1));BIASADD(pA0,pA1,0);CMASK(pA0,pA1,0);
  START(pA0,pA1);
  _Pragma("unroll") for(int r=0;r<16;++r)pA1[r]=__builtin_amdgcn_exp2f(pA1[r]);
  WAIT_BAR(0);
  DMA_K(3,0);DMA_V(1,SLOTB);
  ROT();
  kload8(kf,kp0+sl_cur);
  WAIT_BAR(2);
  s16x4 vlo[8],vhi[8]; u32x4 pw0,pw1,pw2,pw3;
  #define PKW(P,B) cvtpk_s(P[B],P[B+1])
  #define PAF(k) __builtin_bit_cast(bf16x8,pw##k)
  #define VFR(i) (bf16x8){vlo[i][0],vlo[i][1],vlo[i][2],vlo[i][3],vhi[i][0],vhi[i][1],vhi[i][2],vhi[i][3]}
  #define PIN(x) asm volatile("":"+v"(x))
  #define MX3(a,b,c) __builtin_fmaxf(__builtin_fmaxf((a),(b)),(c))
  #define GAPA(MF,A0,A1,A2,A3,W0,W1,PW) do{ MF; sacc+=A0; sacc+=A1; sacc+=A2; sacc+=A3; PIN(sacc); W0; W1; PIN(PW); SBAR(); }while(0)
  #define EX(v) __builtin_amdgcn_exp2f(v)
  #define GAPB(MF,X,B) do{ MF; X[B]=EX(X[B]); X[B+1]=EX(X[B+1]); X[B+2]=EX(X[B+2]); X[B+3]=EX(X[B+3]); PIN(X); SBAR(); }while(0)
  #define VRD(i) do{ vlo[i]=vtr(vp_+(((i)>>2)*4096+((i)&3)*1024)); vhi[i]=vtr(vp_+(((i)>>2)*4096+((i)&3)*1024+512)); }while(0)
  #define KRD(G,j) do{ if(G){ kload2(kf,kp0+sl_next,j); SBAR(); } }while(0)
  #define STEP(C0,C1,P0,P1,t,GK,GV,GL) do{ SBAR(); \
    const lds_cptr vp_=vp0+sl_prev; \
    VRD(0); SBAR(); float sacc=(P0[0]+P0[1]); \
    GAPA(C0=(BIAS?__builtin_amdgcn_mfma_f32_32x32x16_bf16(kf[0],qr[0],f32x16{},0,0,0):__builtin_amdgcn_mfma_f32_32x32x16_bf16(kf[0],qr[0],negm,0,0,0)), P0[2],P0[3],P0[4],P0[5],     pw0[0]=PKW(P0,0), pw0[1]=PKW(P0,2), pw0); \
    VRD(4); SBAR(); GAPA(C1=(BIAS?__builtin_amdgcn_mfma_f32_32x32x16_bf16(kf[1],qr[0],f32x16{},0,0,0):__builtin_amdgcn_mfma_f32_32x32x16_bf16(kf[1],qr[0],negm,0,0,0)), P0[6],P0[7],P0[8],P0[9],     pw0[2]=PKW(P0,4), pw0[3]=PKW(P0,6), pw0); \
    VRD(1); SBAR(); GAPA(C0=__builtin_amdgcn_mfma_f32_32x32x16_bf16(kf[2],qr[1],C0,0,0,0),   P0[10],P0[11],P0[12],P0[13], pw1[0]=PKW(P0,8), pw1[1]=PKW(P0,10), pw1); \
    VRD(5); SBAR(); GAPA(C1=__builtin_amdgcn_mfma_f32_32x32x16_bf16(kf[3],qr[1],C1,0,0,0),   P0[14],P0[15],P1[0],P1[1],   pw1[2]=PKW(P0,12),pw1[3]=PKW(P0,14), pw1); \
    VRD(2); SBAR(); GAPA(C0=__builtin_amdgcn_mfma_f32_32x32x16_bf16(kf[4],qr[2],C0,0,0,0),   P1[2],P1[3],P1[4],P1[5],     pw2[0]=PKW(P1,0), pw2[1]=PKW(P1,2), pw2); \
    VRD(6); SBAR(); GAPA(C1=__builtin_amdgcn_mfma_f32_32x32x16_bf16(kf[5],qr[2],C1,0,0,0),   P1[6],P1[7],P1[8],P1[9],     pw2[2]=PKW(P1,4), pw2[3]=PKW(P1,6), pw2); \
    VRD(3); SBAR(); GAPA(C0=__builtin_amdgcn_mfma_f32_32x32x16_bf16(kf[6],qr[3],C0,0,0,0),   P1[10],P1[11],P1[12],P1[13], pw3[0]=PKW(P1,8), pw3[1]=PKW(P1,10), pw3); \
    VRD(7); SBAR(); GAPA(C1=__builtin_amdgcn_mfma_f32_32x32x16_bf16(kf[7],qr[3],C1,0,0,0),   P1[14],P1[15],0.f,0.f,       pw3[2]=PKW(P1,12),pw3[3]=PKW(P1,14), pw3); \
    l_reg+=sacc; \
    if(GK){DMA_K((t)+3,sl_cur);} if(GV){DMA_V((t)+1,sl_next);} \
    BIASADD(C0,C1,t); CMASK(C0,C1,t); \
    if(!FIXED){ float a=MX3(C0[0],C0[1],C1[0]),b=MX3(C0[2],C0[3],C1[1]); a=MX3(a,C1[2],C1[3]); \
      _Pragma("unroll") for(int r=4;r<16;r+=4){a=MX3(a,C0[r],C0[r+1]);b=MX3(b,C0[r+2],C0[r+3]);a=MX3(a,C1[r],C1[r+1]);b=MX3(b,C1[r+2],C1[r+3]);} \
      float rm=__builtin_fmaxf(a,b); { auto rr=__builtin_amdgcn_permlane32_swap(__float_as_uint(rm),__float_as_uint(rm),false,false); rm=__builtin_fmaxf(__uint_as_float(rr[0]),__uint_as_float(rr[1])); } \
      resc=false; \
      if(__builtin_expect(__any(rm>(float)THRL),0)){ const float dl=__builtin_fmaxf(rm,0.f); mhat+=dl; \
        _Pragma("unroll") for(int r=0;r<16;++r){C0[r]-=dl;C1[r]-=dl;} \
        if(!BIAS){ _Pragma("unroll") for(int r=0;r<16;++r)negm[r]=-mhat; asm volatile("":"+v"(negm)); } \
        const float f=__builtin_amdgcn_exp2f(-dl); l_reg*=f; if(hi==0)wsf[r32]=f; resc=true; } } \
    SBAR(); \
    GAPB(o[0]=__builtin_amdgcn_mfma_f32_32x32x16_bf16(PAF(0),VFR(0),o[0],0,0,0), C0,0); \
    GAPB(o[1]=__builtin_amdgcn_mfma_f32_32x32x16_bf16(PAF(0),VFR(4),o[1],0,0,0), C0,4); \
    KRD(GL,0); GAPB(o[0]=__builtin_amdgcn_mfma_f32_32x32x16_bf16(PAF(1),VFR(1),o[0],0,0,0), C0,8); \
    KRD(GL,1); GAPB(o[1]=__builtin_amdgcn_mfma_f32_32x32x16_bf16(PAF(1),VFR(5),o[1],0,0,0), C0,12); \
    KRD(GL,2); GAPB(o[0]=__builtin_amdgcn_mfma_f32_32x32x16_bf16(PAF(2),VFR(2),o[0],0,0,0), C1,0); \
    KRD(GL,3); GAPB(o[1]=__builtin_amdgcn_mfma_f32_32x32x16_bf16(PAF(2),VFR(6),o[1],0,0,0), C1,4); \
    GAPB(o[0]=__builtin_amdgcn_mfma_f32_32x32x16_bf16(PAF(3),VFR(3),o[0],0,0,0), C1,8); \
    GAPB(o[1]=__builtin_amdgcn_mfma_f32_32x32x16_bf16(PAF(3),VFR(7),o[1],0,0,0), C1,12); \
    }while(0)
  int t=1;
  #undef CMASK
  #define CMASK(P0,P1,t) do{}while(0)
  for(;t+5<NT;t+=2){
    STEP(pB0,pB1,pA0,pA1,t,true,true,true);     WAIT_BAR(2); RESC(); ROT();
    STEP(pA0,pA1,pB0,pB1,t+1,true,true,true);   WAIT_BAR(2); RESC(); ROT();
  }
  #undef CMASK
  #define CMASK(P0,P1,t) do{ if(CAUSAL){int jb_=(t)-(NT-4); if(jb_>=0)cmask(P0,P1,jb_,qrel,hi);} }while(0)
  #define ENDW(tt) do{ if((tt)+3<NT){WAIT_BAR(2);} else if((tt)+2<NT){WAIT_BAR(1);} else {WAIT_BAR(0);} }while(0)
  for(;t+1<NT;t+=2){
    STEP(pB0,pB1,pA0,pA1,t,(t+3<NT),(t+1<NT),(t+1<NT));       ENDW(t);   RESC(); ROT();
    STEP(pA0,pA1,pB0,pB1,t+1,(t+4<NT),(t+2<NT),(t+2<NT));     ENDW(t+1); RESC(); ROT();
  }
  STEP(pB0,pB1,pA0,pA1,NT-1,false,false,false); RESC();
  { float sacc=pB0[0]+pB0[1]; _Pragma("unroll") for(int r=2;r<16;++r)sacc+=pB0[r]; _Pragma("unroll") for(int r=0;r<16;++r)sacc+=pB1[r]; l_reg+=sacc;
    pw0=(u32x4){PKW(pB0,0),PKW(pB0,2),PKW(pB0,4),PKW(pB0,6)};pw1=(u32x4){PKW(pB0,8),PKW(pB0,10),PKW(pB0,12),PKW(pB0,14)};pw2=(u32x4){PKW(pB1,0),PKW(pB1,2),PKW(pB1,4),PKW(pB1,6)};pw3=(u32x4){PKW(pB1,8),PKW(pB1,10),PKW(pB1,12),PKW(pB1,14)};
    SBAR(); pv(o,vb0+sl_cur,PAF(0),PAF(1),PAF(2),PAF(3)); }
  #undef PKW
  #undef PAF
  #undef VFR
  #undef PIN
  #undef MX3
  #undef GAPA
  #undef GAPB
  #undef EX
  #undef VRD
  #undef KRD
  #undef STEP
  #undef ENDW
  int tid_e=threadIdx.x; asm volatile("":"+v"(tid_e)); const int lane_e=tid_e&63,r32_e=lane_e&31,hi_e=lane_e>>5; float*wsf_e=(float*)(shm+LDS_WS)+wid*64;
  {auto rr=__builtin_amdgcn_permlane32_swap(__float_as_uint(l_reg),__float_as_uint(l_reg),false,false);l_reg=__uint_as_float(rr[0])+__uint_as_float(rr[1]);}
  if(hi_e==0)wsf_e[32+r32_e]=l_reg;asm volatile("s_waitcnt lgkmcnt(0)":::"memory");
  float rli[16];
  #pragma unroll
  for(int r=0;r<16;++r)rli[r]=__builtin_amdgcn_rcpf(wsf_e[32+crow(r,hi_e)]);
  bf16*Ow=Ob+(long)(wid*QBLK)*OP;
  { bf16*stg=(bf16*)(shm+LDS_OST)+wid*2048;
    #pragma unroll
    for(int r=0;r<16;++r){const int orow=crow(r,hi_e);
      #pragma unroll
      for(int d0=0;d0<2;++d0)stg[orow*64+d0*32+r32_e]=__float2bfloat16(o[d0][r]*rli[r]);}
    asm volatile("s_waitcnt lgkmcnt(0)":::"memory");
    #pragma unroll
    for(int i=0;i<4;++i){const int row=i*8+(lane_e>>3),ch=lane_e&7; const u32x4 v=*(const u32x4*)(stg+row*64+ch*8); ATTN_STORE16(Ow+(long)row*OP+ch*8,v);} }
  asm volatile("s_waitcnt lgkmcnt(0)\n\ts_barrier":::"memory");
  #undef DMA_K
  #undef DMA_V
  #undef CMASK
  #undef BIASADD
  #undef START
  #undef RESC
  #undef ROT
}
constexpr int ATTN_LDS_BYTES=LDS_BYTES;
#undef SBAR
#undef WAIT_BAR
}
#define GAS __attribute__((address_space(1)))
#define LAS __attribute__((address_space(3)))
typedef unsigned short bf16;
typedef unsigned v4u __attribute__((ext_vector_type(4)));
typedef unsigned v2u __attribute__((ext_vector_type(2)));
typedef float f32x4 __attribute__((ext_vector_type(4)));
typedef short bf16x8 __attribute__((ext_vector_type(8)));
typedef float f32x16 __attribute__((ext_vector_type(16)));
#define LDS_WAIT() asm volatile("s_waitcnt lgkmcnt(0)" ::: "memory")

constexpr int NWAVES = 8;
constexpr int M = 32768, DM = 1024, FF = 2816, SEQ = 8192, NBATCH = 4, MEML = 256;
constexpr int NFOX = 2560, NFOX_SRC = 2572, NGM = 1792;
constexpr float EPS = 1e-6f;
constexpr size_t MiB = 1u << 20;
constexpr size_t WS_WFI = 1 * MiB;
constexpr size_t WS_WFO = 45 * MiB;
constexpr size_t WS_WFOX = 67 * MiB;
constexpr size_t WS_WGM = 72 * MiB;
constexpr size_t WS_WOUT = 76 * MiB;
constexpr size_t WS_WMKV = 80 * MiB;
constexpr size_t WS_WSB = 82 * MiB;
constexpr size_t WS_MEMN = 83 * MiB;
constexpr size_t WS_KVM = 85 * MiB;
constexpr size_t WS_LOGF = 87 * MiB;
constexpr size_t WS_BIAS = 89 * MiB;
constexpr size_t WS_SSQ = 91 * MiB;
constexpr size_t WS_XN = 96 * MiB;
constexpr size_t WS_CAT = 160 * MiB;
constexpr size_t WS_G = 224 * MiB;
constexpr size_t WS_END = 400 * MiB;
constexpr int LDS_BYTES = 132096;

__device__ __forceinline__ unsigned f2bf(float f) { unsigned u = __builtin_bit_cast(unsigned, f); return (u + 0x7fffu + ((u >> 16) & 1u)) >> 16; }
__device__ __forceinline__ unsigned pk2(float lo, float hi) { return f2bf(lo) | (f2bf(hi) << 16); }
__device__ __forceinline__ float bf2f(unsigned short b) { return __builtin_bit_cast(float, (unsigned)b << 16); }
__device__ __forceinline__ float wave_sum(float v) {
#pragma unroll
    for (int o = 1; o < 64; o <<= 1) v += __shfl_xor(v, o);
    return v;
}

__device__ __forceinline__ void conv_item(const float* W, int K, int Nsrc, int sc0, bf16* WTrow0, int k0, LAS float* scr, int lane, const float* gain = nullptr) {
    {
        f32x4 w[8]; const int c4 = lane & 7;
#pragma unroll
        for (int i = 0; i < 8; ++i) w[i] = *(const f32x4*)(W + (size_t)(k0 + 8 * i + (lane >> 3)) * Nsrc + sc0 + 4 * c4);
#pragma unroll
        for (int i = 0; i < 8; ++i) { const int kk = 8 * i + (lane >> 3); const float gk = gain ? gain[k0 + kk] : 1.0f; LAS float* d = scr + kk * 33 + 4 * c4;
            d[0] = w[i].x * gk; d[1] = w[i].y * gk; d[2] = w[i].z * gk; d[3] = w[i].w * gk; }
    }
    LDS_WAIT(); asm volatile("" ::: "memory");
    const int c = lane & 7;
#pragma unroll
    for (int j = 0; j < 4; ++j) { const int n = (lane >> 3) + 8 * j; const LAS float* s = scr + (8 * c) * 33 + n;
        v4u o; o.x = pk2(s[0 * 33], s[1 * 33]); o.y = pk2(s[2 * 33], s[3 * 33]); o.z = pk2(s[4 * 33], s[5 * 33]); o.w = pk2(s[6 * 33], s[7 * 33]);
        *(v4u*)(WTrow0 + (size_t)n * K + k0 + 8 * c) = o; }
    LDS_WAIT(); asm volatile("" ::: "memory");
}
__device__ __forceinline__ int map_plain(int n0) { return n0; }
__device__ __forceinline__ int map_swiglu(int n0) { const int t = n0 >> 8, j = n0 & 255; return (j < 128) ? 128 * t + j : FF + 128 * t + (j - 128); }
__device__ __forceinline__ int map_head(int n0, int gap_tile, int gap) { const int t = n0 >> 8, p = n0 & 255, bj = p >> 7, wc = (p >> 5) & 3; return 256 * t + 64 * wc + 32 * bj + (t >= gap_tile ? gap : 0); }

struct Args { const float* in[22]; float* out; unsigned char* ws; };

__device__ __forceinline__ void norm_row(const float* xrow, const f32x4 (&gn)[4], bf16* orow, int lane, f32x4 (&v)[4]) {
    const f32x4* xr = (const f32x4*)xrow + lane; float s = 0.f;
#pragma unroll
    for (int j = 0; j < 4; ++j) { v[j] = xr[64 * j]; s += (v[j].x * v[j].x + v[j].y * v[j].y) + (v[j].z * v[j].z + v[j].w * v[j].w); }
    const float rstd = 1.0f / sqrtf(wave_sum(s) * (1.f / DM) + EPS);
    unsigned long long* o8 = (unsigned long long*)orow + lane;
#pragma unroll
    for (int j = 0; j < 4; ++j) { v[j] = v[j] * rstd * gn[j]; o8[64 * j] = (unsigned long long)pk2(v[j].x, v[j].y) | ((unsigned long long)pk2(v[j].z, v[j].w) << 32); }
}

__device__ __forceinline__ void gmlp_unit(int rc, int g, const bf16* PROJ, const bf16* WSB, const float* bs, bf16* CAT, LAS unsigned char* lds, int tid_in) {
    int tid = tid_in; asm volatile("" : "+v"(tid));
    const int lane = tid & 63, wid = tid >> 6, r32 = lane & 31, hi = lane >> 5;
    LAS bf16* VT = (LAS bf16*)lds;
    {
        const int row = tid >> 2, seg = tid & 3;
        const bf16* src = PROJ + (size_t)(rc * 128 + row) * NGM + 768 + g * 64 + seg * 16;
        const bf16x8 a = *(const bf16x8*)src, b = *(const bf16x8*)(src + 8);
#pragma unroll
        for (int e = 0; e < 8; ++e) { VT[(seg * 16 + e) * 136 + row] = (bf16)a[e]; VT[(seg * 16 + 8 + e) * 136 + row] = (bf16)b[e]; }
    }
    __syncthreads();
    const int tb = wid & 3, db = wid >> 2;
    f32x16 acc; { float z0_; asm volatile("v_mov_b32 %0, 0" : "=v"(z0_));
#pragma unroll
      for (int r = 0; r < 16; ++r) acc[r] = z0_; }
    const bf16* wrow = WSB + ((size_t)g * 128 + tb * 32 + r32) * 128 + 8 * hi;
    const LAS bf16* vrow = VT + (db * 32 + r32) * 136 + 8 * hi;
    const int nks = 2 * (tb + 1);
    for (int ks = 0; ks < nks; ++ks) {
        const bf16x8 A = *(const LAS bf16x8*)(vrow + 16 * ks); const bf16x8 Bf = *(const bf16x8*)(wrow + 16 * ks);
        acc = __builtin_amdgcn_mfma_f32_32x32x16_bf16(A, Bf, acc, 0, 0, 0);
    }
    const int t = tb * 32 + r32; const float bsv = bs[g * 128 + t];
    const size_t row = (size_t)rc * 128 + t;
    const bf16* up = PROJ + row * NGM + g * 64 + db * 32 + 4 * hi;
    bf16* op = CAT + row * DM + g * 64 + db * 32 + 4 * hi;
#pragma unroll
    for (int q = 0; q < 4; ++q) {
        const v2u uv = *(const v2u*)(up + 8 * q);
        const float u0 = __builtin_bit_cast(float, uv.x << 16), u1 = __builtin_bit_cast(float, uv.x & 0xffff0000u), u2 = __builtin_bit_cast(float, uv.y << 16), u3 = __builtin_bit_cast(float, uv.y & 0xffff0000u);
        v2u o; o.x = pk2(u0 * (acc[4 * q] + bsv), u1 * (acc[4 * q + 1] + bsv)); o.y = pk2(u2 * (acc[4 * q + 2] + bsv), u3 * (acc[4 * q + 3] + bsv));
        *(v2u*)(op + 8 * q) = o;
    }
    __syncthreads();
}

#define CW_XCNT(j) (128 + 64 * (j))
#define CW_XSUB(j) (128 + 64 * 16 + 64 * (j))
#define CW_TOP (128 + 64 * 32)
constexpr int CTL_BYTES = 16384;
__device__ __forceinline__ unsigned xcc_id() { return (unsigned)__builtin_amdgcn_s_getreg((3 << 11) | 20) & 0xFu; }
__device__ __forceinline__ void grid_bar(unsigned* ctl, volatile LAS unsigned* st, unsigned k, unsigned G) {
    asm volatile("s_waitcnt vmcnt(0)" ::: "memory");
    __syncthreads();
    int t = threadIdx.x; asm volatile("" : "+v"(t));
    if (t == 0) {
        const unsigned x = st[0], nloc = st[1];
        const unsigned old = __hip_atomic_fetch_add(ctl + CW_XSUB(x), 1u, __ATOMIC_RELAXED, __HIP_MEMORY_SCOPE_AGENT);
        if (old + 1u == k * nloc) {
            __builtin_amdgcn_fence(__ATOMIC_RELEASE, "agent");
            asm volatile("s_waitcnt vmcnt(0)" ::: "memory");
            __hip_atomic_fetch_add(ctl + CW_TOP, nloc, __ATOMIC_RELAXED, __HIP_MEMORY_SCOPE_AGENT);
        }
        while (__hip_atomic_load(ctl + CW_TOP, __ATOMIC_RELAXED, __HIP_MEMORY_SCOPE_AGENT) < k * G) __builtin_amdgcn_s_sleep(2);
        __builtin_amdgcn_fence(__ATOMIC_ACQUIRE, "agent");
        asm volatile("s_waitcnt vmcnt(0)" ::: "memory");
    }
    __syncthreads();
}
__global__ void __launch_bounds__(NWAVES * 64, 2) fwd_megakernel(Args args) {
    extern __shared__ __attribute__((aligned(16))) unsigned char lds[];
    cg::grid_group grid = cg::this_grid();
    LAS unsigned char* ldsl = (LAS unsigned char*)lds;
    const int tid = threadIdx.x, lane = tid & 63, wave = __builtin_amdgcn_readfirstlane(tid >> 6);
    const int G = gridDim.x, bx = blockIdx.x;
    const int vcu = (G % 8 == 0) ? (bx % 8) * (G / 8) + bx / 8 : bx;
    const int gw = vcu * NWAVES + wave, NGW = G * NWAVES;
    unsigned char* ws = args.ws;
    const float* x_in = args.in[0]; float* xres = args.out;
#define WFI ((bf16*)(wsl() + WS_WFI))
#define WFO ((bf16*)(wsl() + WS_WFO))
#define WFOX ((bf16*)(wsl() + WS_WFOX))
#define WGM ((bf16*)(wsl() + WS_WGM))
#define WOUT ((bf16*)(wsl() + WS_WOUT))
#define WMKV ((bf16*)(wsl() + WS_WMKV))
#define WSB ((bf16*)(wsl() + WS_WSB))
#define MEMN ((bf16*)(wsl() + WS_MEMN))
#define KVM ((bf16*)(wsl() + WS_KVM))
#define LOGF ((float*)(wsl() + WS_LOGF))
#define BIASA ((float*)(wsl() + WS_BIAS))
#define XN ((bf16*)(wsl() + WS_XN))
#define SSQ ((float*)(wsl() + WS_SSQ))
#define CAT ((bf16*)(wsl() + WS_CAT))
#define GB ((bf16*)(wsl() + WS_G))
    auto wsl = [&]() __attribute__((always_inline)) { unsigned char* p = ws; asm volatile("" : "+s"(p)); return p; };

    volatile LAS unsigned* bst = (volatile LAS unsigned*)(ldsl + 131072 + 16);
    if (tid == 0) { const unsigned x_ = xcc_id(); bst[0] = x_; __hip_atomic_fetch_add((unsigned*)wsl() + CW_XCNT(x_), 1u, __ATOMIC_RELAXED, __HIP_MEMORY_SCOPE_AGENT); }
    {
        LAS float* scr = (LAS float*)(ldsl + wave * 16384);
        constexpr int I_FI = 16 * 176, I_FO = 44 * 32, I_FOX = 16 * 80, I_GM = 16 * 56, I_WO = 16 * 32, I_KV = 16 * 16;
        constexpr int NITEMS = 4 * I_FI + 4 * I_FO + I_FOX + I_GM + 2 * I_WO + 2 * I_KV;
        for (int it = gw; it < NITEMS; it += NGW) {
            int r = it;
            if (r < 4 * I_FI) { const int mi = r / I_FI; r -= mi * I_FI; const int layer = mi >> 1, which = mi & 1; const int kb = r / 176, nb = r % 176;
                const float* W = args.in[which ? 7 : 3] + (size_t)layer * DM * 2 * FF;
                conv_item(W, DM, 2 * FF, map_swiglu(32 * nb), WFI + (size_t)mi * 5632 * DM + (size_t)(32 * nb) * DM, 64 * kb, scr, lane, args.in[which ? 6 : 2] + layer * DM); continue; }
            r -= 4 * I_FI;
            if (r < 4 * I_FO) { const int mi = r / I_FO; r -= mi * I_FO; const int layer = mi >> 1, which = mi & 1; const int kb = r / 32, nb = r % 32;
                const float* W = args.in[which ? 8 : 4] + (size_t)layer * FF * DM;
                conv_item(W, FF, DM, map_plain(32 * nb), WFO + (size_t)mi * DM * FF + (size_t)(32 * nb) * FF, 64 * kb, scr, lane); continue; }
            r -= 4 * I_FO;
            if (r < I_FOX) { const int kb = r / 80, nb = r % 80;
                conv_item(args.in[14], DM, NFOX_SRC, map_head(32 * nb, 9, 12), WFOX + (size_t)(32 * nb) * DM, 64 * kb, scr, lane, args.in[5]); continue; }
            r -= I_FOX;
            if (r < I_GM) { const int kb = r / 56, nb = r % 56;
                conv_item(args.in[18], DM, NGM, map_head(32 * nb, 99, 0), WGM + (size_t)(32 * nb) * DM, 64 * kb, scr, lane, args.in[5] + DM); continue; }
            r -= I_GM;
            if (r < 2 * I_WO) { const int mi = r / I_WO; r -= mi * I_WO; const int kb = r / 32, nb = r % 32;
                conv_item(args.in[9] + (size_t)mi * DM * DM, DM, DM, map_plain(32 * nb), WOUT + (size_t)mi * DM * DM + (size_t)(32 * nb) * DM, 64 * kb, scr, lane); continue; }
            r -= 2 * I_WO;
            { const int mi = r / I_KV; r -= mi * I_KV; const int kb = r / 16, nb = r % 16;
                conv_item(args.in[11] + (size_t)mi * DM * 512, DM, 512, map_head(32 * nb, 99, 0), WMKV + (size_t)mi * 512 * DM + (size_t)(32 * nb) * DM, 64 * kb, scr, lane); }
        }
        for (int i = bx * (NWAVES * 64) + tid; i < 12 * 128 * 128; i += G * NWAVES * 64) { const int s = i & 127, t = (i >> 7) & 127; WSB[i] = (s <= t) ? (bf16)f2bf(args.in[20][i]) : (bf16)0; }
        { f32x4 gn[4], v[4];
#pragma unroll
          for (int j = 0; j < 4; ++j) gn[j] = ((const f32x4*)args.in[10])[lane + 64 * j];
          for (int m = gw; m < NBATCH * MEML; m += NGW) norm_row(args.in[1] + (size_t)m * DM, gn, MEMN + (size_t)m * DM, lane, v); }
        for (int m = gw; m < M; m += NGW) {
            const f32x4* xr = (const f32x4*)(args.in[0] + (size_t)m * DM) + lane; unsigned long long* o8 = (unsigned long long*)(XN + (size_t)m * DM) + lane; float ss = 0.f;
#pragma unroll
            for (int j = 0; j < 4; ++j) { const f32x4 v = xr[64 * j]; ss += (v.x * v.x + v.y * v.y) + (v.z * v.z + v.w * v.w); o8[64 * j] = (unsigned long long)pk2(v.x, v.y) | ((unsigned long long)pk2(v.z, v.w) << 32); }
            ss = wave_sum(ss); if (lane == 0) SSQ[m] = ss;
        }
        for (int i = bx * (NWAVES * 64) + tid; i < 5 * M; i += G * NWAVES * 64) SSQ[M + i] = 0.f;
        __syncthreads();
    }

    grid.sync();
    if (tid == 0) bst[1] = __hip_atomic_load((unsigned*)wsl() + CW_XCNT(bst[0]), __ATOMIC_RELAXED, __HIP_MEMORY_SCOPE_AGENT);
    __syncthreads();
    unsigned nbar = 0;
#define GBAR() do { ++nbar; grid_bar((unsigned*)wsl(), bst, nbar, (unsigned)G); } while (0)
#pragma nounroll
    for (int half = 0; half < 4; ++half) {
        const int layer = half >> 1, which = half & 1;
        int tid = threadIdx.x; asm volatile("" : "+v"(tid)); const int lane = tid & 63;
        const float* xin = (half == 0) ? x_in : xres;
        { pg8::Gemm g{XN, WFI + (size_t)half * 5632 * DM, M, 2 * FF, DM}; pg8::StaticOrder S; S.init(M, 2 * FF, G, bx);
          pg8::EpiSwiGLU E{GB, FF, SSQ + (size_t)(layer * 3 + (which ? 2 : 0)) * M};
          pg8::gemm_phase<pg8::EpiSwiGLU, pg8::StaticOrder, true, true>(ldsl, g, S, E); }
        GBAR();
        { pg8::Gemm g{GB, WFO + (size_t)half * DM * FF, M, DM, FF}; pg8::StaticOrder S; S.init(M, DM, G, bx);
          if (half == 3) { pg8::EpiRes<false> E{xin, xres, nullptr, nullptr, 0.5f}; pg8::gemm_phase<pg8::EpiRes<false>, pg8::StaticOrder, true, true>(ldsl, g, S, E); break; }
          pg8::EpiRes<true> E{xin, xres, XN, SSQ + (size_t)(layer * 3 + (which ? 3 : 1)) * M, 0.5f};
          pg8::gemm_phase<pg8::EpiRes<true>, pg8::StaticOrder, true, true>(ldsl, g, S, E); }
        GBAR();
        if (which == 1) continue;
        const float* ssq_mix = SSQ + (size_t)(layer * 3 + 1) * M;
        if (layer == 0) {
#pragma nounroll
            for (int l2 = 0; l2 < 2; ++l2) {
                pg8::Gemm g{MEMN, WMKV + (size_t)l2 * 512 * DM, NBATCH * MEML, 512, DM}; pg8::StaticOrder S; S.init(NBATCH * MEML, 512, G, (bx + G - 8 * l2) % G);
                pg8::EpiProj<2> E{KVM + (size_t)l2 * 1024 * 512, 512, nullptr, args.in[13] + l2 * 64, nullptr, nullptr};
                pg8::gemm_phase<pg8::EpiProj<2>, pg8::StaticOrder, true, true>(ldsl, g, S, E);
                __syncthreads();
            }
            {
                LAS float* FWT = (LAS float*)ldsl;
                for (int i = tid; i < 12 * DM; i += NWAVES * 64) { const int h = i % 12, k = i / 12; FWT[h * DM + k] = args.in[14][(size_t)k * NFOX_SRC + 2304 + h] * args.in[5][k]; }
                __syncthreads();
                const float bfl = (lane < 12) ? args.in[15][lane] : 0.f;
                int gwl = gw; asm volatile("" : "+s"(gwl));
                for (int m = gwl; m < M; m += NGW) {
                    const v4u xa = *((const v4u*)(XN + (size_t)m * DM) + lane), xc = *((const v4u*)(XN + (size_t)m * DM + 512) + lane);
                    float xv[16];
#pragma unroll
                    for (int e = 0; e < 4; ++e) { xv[2 * e] = __builtin_bit_cast(float, xa[e] << 16); xv[2 * e + 1] = __builtin_bit_cast(float, xa[e] & 0xffff0000u);
                                                  xv[8 + 2 * e] = __builtin_bit_cast(float, xc[e] << 16); xv[8 + 2 * e + 1] = __builtin_bit_cast(float, xc[e] & 0xffff0000u); }
                    float fl = 0.f;
#pragma unroll
                    for (int h = 0; h < 12; ++h) {
                        const LAS f32x4* wp = (const LAS f32x4*)(FWT + h * DM + 8 * lane);
                        const f32x4 w0 = wp[0], w1 = wp[1], w2 = wp[128], w3 = wp[129];
                        float p = ((xv[0] * w0.x + xv[1] * w0.y) + (xv[2] * w0.z + xv[3] * w0.w)) + ((xv[4] * w1.x + xv[5] * w1.y) + (xv[6] * w1.z + xv[7] * w1.w))
                                + ((xv[8] * w2.x + xv[9] * w2.y) + (xv[10] * w2.z + xv[11] * w2.w)) + ((xv[12] * w3.x + xv[13] * w3.y) + (xv[14] * w3.z + xv[15] * w3.w));
                        p = wave_sum(p); if (lane == h) fl = p;
                    }
                    if (lane < 12) { const float rs = 1.0f / sqrtf(ssq_mix[m] * (1.0f / 1024.0f) + EPS); const float f = fl * rs + bfl;
                        const float lf = fminf(f, 0.f) - 0.6931471805599453f * __builtin_amdgcn_logf(1.0f + __builtin_amdgcn_exp2f(-1.4426950408889634f * fabsf(f)));
                        LOGF[(size_t)((m >> 13) * 12 + lane) * SEQ + (m & (SEQ - 1))] = lf; }
                }
                __syncthreads();
            }
            { pg8::Gemm g{XN, WFOX, M, NFOX, DM}; pg8::StaticOrder S; S.init(M, NFOX, G, bx);
              pg8::EpiProj<0> E{GB, NFOX, args.in[16], args.in[17], args.in[12], ssq_mix};
              pg8::gemm_phase<pg8::EpiProj<0>, pg8::StaticOrder, true, true>(ldsl, g, S, E); }
            GBAR();
            if (bx < 48) {
                LAS double* sw = (LAS double*)ldsl;
                const f32x4* lf4 = (const f32x4*)(LOGF + (size_t)bx * SEQ) + tid * 4;
                double loc[16]; double run = 0.0;
#pragma unroll
                for (int j = 0; j < 4; ++j) { const f32x4 q = lf4[j]; run += (double)q.x; loc[4 * j] = run; run += (double)q.y; loc[4 * j + 1] = run; run += (double)q.z; loc[4 * j + 2] = run; run += (double)q.w; loc[4 * j + 3] = run; }
                double sc = run;
#pragma unroll
                for (int o = 1; o < 64; o <<= 1) { const double y = __shfl_up(sc, o); if (lane >= o) sc += y; }
                if (lane == 63) sw[wave] = sc;
                __syncthreads();
                double woff = 0.0;
                for (int w2 = 0; w2 < wave; ++w2) woff += sw[w2];
                const double excl = sc - run + woff;
                f32x4* bo = (f32x4*)(BIASA + (size_t)bx * SEQ) + tid * 4;
#pragma unroll
                for (int j = 0; j < 4; ++j) { f32x4 o; o.x = (float)(-(excl + loc[4 * j]) * 1.4426950408889634); o.y = (float)(-(excl + loc[4 * j + 1]) * 1.4426950408889634);
                    o.z = (float)(-(excl + loc[4 * j + 2]) * 1.4426950408889634); o.w = (float)(-(excl + loc[4 * j + 3]) * 1.4426950408889634); bo[j] = o; }
                __syncthreads();
            }
        } else {
            pg8::Gemm g{XN, WGM, M, NGM, DM}; pg8::StaticOrder S; S.init(M, NGM, G, bx);
            pg8::EpiProj<1> E{GB, NGM, nullptr, args.in[19], args.in[12] + 64, ssq_mix};
            pg8::gemm_phase<pg8::EpiProj<1>, pg8::StaticOrder, true, true>(ldsl, g, S, E);
        }
        GBAR();
        if (layer == 0) {
            const attn_body::bf16* P = (const attn_body::bf16*)GB; attn_body::bf16* C = (attn_body::bf16*)CAT;
            float mq = fabsf(args.in[16][lane]), mk = fabsf(args.in[17][lane]);
#pragma unroll
            for (int o = 1; o < 64; o <<= 1) { mq = fmaxf(mq, __shfl_xor(mq, o)); mk = fmaxf(mk, __shfl_xor(mk, o)); }
            const float bound = __builtin_bit_cast(float, __builtin_amdgcn_readfirstlane(__builtin_bit_cast(int, 64.f * pg8::ATT_C2 * mq * mk * 1.02f + 0.25f)));
            const bool fixed_ok = bound <= 60.f;
            unsigned* qctr = (unsigned*)wsl();
            LAS int* qslot = (LAS int*)(ldsl + 131072);
            for (;;) {
                int tidq = threadIdx.x; asm volatile("" : "+v"(tidq)); const int laneq = tidq & 63;
                if (tidq == 0) *qslot = (int)atomicAdd(qctr, 1u);
                __syncthreads();
                const int idx = __builtin_amdgcn_readfirstlane(*qslot);
                if (idx >= 1536 + 512) break;
                if (idx >= 1536) {
                    const int u = idx - 1536, bm = u >> 5, qb = u & 31, b = bm >> 2, mh = bm & 3; const size_t rowq = (size_t)b * SEQ + qb * 256;
                    const attn_body::bf16* KV = (const attn_body::bf16*)KVM;
                    attn_body::attn_unit<8, false, false, false, 512, DM>(P + rowq * NFOX + 2304 + mh * 64, NFOX, KV + (size_t)(b * MEML) * 512 + mh * 64, KV + (size_t)(b * MEML) * 512 + 256 + mh * 64,
                                                                      C + rowq * DM + 768 + mh * 64, 4, nullptr, nullptr, 0.f, (char*)lds);
                    continue;
                }
                const int qb = 31 - idx / 48, bh = idx % 48, b = bh / 12, h = bh % 12;
                const size_t rowq = (size_t)b * SEQ + qb * 256;
                const float* bb = BIASA + (size_t)bh * SEQ;
                const int NT = 4 * qb + 4;
                if (fixed_ok) {
                    const float bq0 = bb[qb * 256];
                    const int t1 = laneq, t2 = laneq + 64;
                    const bool n1 = (t1 < NT) && (2.f * bound + bb[64 * (t1 < NT ? t1 : 0) + 63] - bq0 >= -48.f);
                    const bool n2 = (t2 < NT) && (2.f * bound + bb[64 * (t2 < NT ? t2 : 0) + 63] - bq0 >= -48.f);
                    const unsigned long long m1 = __ballot(n1), m2 = __ballot(n2);
                    int first = m1 ? (__ffsll((long long)m1) - 1) : (m2 ? 64 + (__ffsll((long long)m2) - 1) : NT);
                    int T0 = first & ~1; if (T0 > NT - 4) T0 = NT - 4;
                    T0 = __builtin_amdgcn_readfirstlane(T0);
                    const size_t rowk = (size_t)b * SEQ + (size_t)T0 * 64;
                    attn_body::attn_unit<8, true, true, true, NFOX, DM>(P + rowq * NFOX + h * 64, NFOX, P + rowk * NFOX + 768 + h * 64, P + rowk * NFOX + 1536 + h * 64,
                                                                    C + rowq * DM + h * 64, NT - T0, bb + T0 * 64, bb + qb * 256, bound, (char*)lds);
                } else {
                    const size_t rowk = (size_t)b * SEQ;
                    attn_body::attn_unit<8, true, true, false, NFOX, DM>(P + rowq * NFOX + h * 64, NFOX, P + rowk * NFOX + 768 + h * 64, P + rowk * NFOX + 1536 + h * 64,
                                                                     C + rowq * DM + h * 64, NT, bb, nullptr, 0.f, (char*)lds);
                }
            }
        } else {
            for (int u = vcu; u < 256 * 12; u += G) gmlp_unit(u / 12, u % 12, GB, WSB, args.in[21], CAT, ldsl, tid);
        }
        if (layer == 1) {
            const int QP = layer == 0 ? NFOX : NGM; const int mqc = layer == 0 ? 2304 : 1536;
            const attn_body::bf16* P = (const attn_body::bf16*)GB; attn_body::bf16* C = (attn_body::bf16*)CAT; const attn_body::bf16* KV = (const attn_body::bf16*)(KVM + (size_t)layer * 1024 * 512);
            for (int u = vcu; u < 512; u += G) {
                const int bm = u >> 5, qb = u & 31, b = bm >> 2, mh = bm & 3; const size_t rowq = (size_t)b * SEQ + qb * 256;
                attn_body::attn_unit<8, false, false, false, 512, DM>(P + rowq * QP + mqc + mh * 64, QP, KV + (size_t)(b * MEML) * 512 + mh * 64, KV + (size_t)(b * MEML) * 512 + 256 + mh * 64,
                                                           C + rowq * DM + 768 + mh * 64, 4, nullptr, nullptr, 0.f, (char*)lds);
            }
        }
        GBAR();
        { pg8::Gemm g{CAT, WOUT + (size_t)layer * DM * DM, M, DM, DM}; pg8::StaticOrder S; S.init(M, DM, G, bx);
          pg8::EpiRes<true> E{xres, xres, XN, SSQ + (size_t)(layer * 3 + 2) * M, 1.0f};
          pg8::gemm_phase<pg8::EpiRes<true>, pg8::StaticOrder, true, true>(ldsl, g, S, E); }
        GBAR();
    }
}

extern "C" void kernel_launch(void* const* d_in, const int* in_sizes, int n_in, void* d_out, int out_size, void* d_ws, size_t ws_size, hipStream_t stream) {
    static int grid_blocks = 0;
    if (grid_blocks == 0) {
        if (n_in != 22 || out_size != M * DM || ws_size < WS_END) { fprintf(stderr, "kernel_launch: unexpected problem (n_in %d, out %d, ws %zu)\n", n_in, out_size, ws_size); grid_blocks = -1; return; }
        int dev = 0, cus = 0, per_cu = 0;
        hipGetDevice(&dev);
        hipDeviceGetAttribute(&cus, hipDeviceAttributeMultiprocessorCount, dev);
        if (hipFuncSetAttribute((const void*)fwd_megakernel, hipFuncAttributeMaxDynamicSharedMemorySize, LDS_BYTES) != hipSuccess) { fprintf(stderr, "kernel_launch: hipFuncSetAttribute failed\n"); grid_blocks = -1; return; }
        if (hipOccupancyMaxActiveBlocksPerMultiprocessor(&per_cu, (const void*)fwd_megakernel, NWAVES * 64, LDS_BYTES) != hipSuccess || per_cu < 1) { fprintf(stderr, "kernel_launch: occupancy query gave %d\n", per_cu); per_cu = 1; }
        (void)hipGetLastError();
        grid_blocks = cus * per_cu;
        if (grid_blocks > 256) grid_blocks = 256;
    }
    if (grid_blocks < 0) return;
    (void)hipMemsetAsync((char*)d_ws, 0, CTL_BYTES, stream);
    Args a{};
    for (int i = 0; i < 22; ++i) a.in[i] = (const float*)d_in[i];
    a.out = (float*)d_out; a.ws = (unsigned char*)d_ws;
    void* kargs[] = {&a};
    hipError_t e = hipLaunchCooperativeKernel((const void*)fwd_megakernel, dim3(grid_blocks), dim3(NWAVES * 64), kargs, LDS_BYTES, stream);
    if (e != hipSuccess) fprintf(stderr, "cooperative launch failed: %s (grid %d)\n", hipGetErrorString(e), grid_blocks);
}
```

```cpp
#include <hip/hip_runtime.h>
#include <hip/hip_cooperative_groups.h>
#include <hip/hip_bf16.h>
#include <cstdio>
#include <cstdint>
#include <cmath>
namespace cg = cooperative_groups;
namespace pg8 {
#define PG8_LAS __attribute__((address_space(3)))
typedef unsigned short bf16_t;
typedef short bf16x8 __attribute__((ext_vector_type(8)));
typedef float f32x4 __attribute__((ext_vector_type(4)));
typedef unsigned u32x4 __attribute__((ext_vector_type(4)));
constexpr int BM = 256, BK = 64, HALF = 128, HTB = HALF * BK * 2  , STAGE_BYTES = 8 * HTB, NXCD = 8, WGM = 8;

__host__ __device__ __forceinline__ int lds_byte(int r, int c) { const int st = (r >> 4) * 2 + (c >> 5), rr = r & 15, cc = c & 31, ob = rr * 64 + cc * 2; return st * 1024 + (ob ^ (((ob >> 9) & 1) << 5)); }
__host__ __device__ __forceinline__ void stage_rc(int b, int& R, int& C) { const int st = b / 1024, sb = b % 1024, swz = sb ^ (((sb >> 9) & 1) << 5); R = (st >> 1) * 16 + swz / 64; C = (st & 1) * 32 + (swz % 64) / 2; }
__host__ __device__ __forceinline__ int perm32(int rho) { const int n = rho >> 4, i = rho & 15; return 8 * (i >> 2) + 4 * n + (i & 3); }

struct Unit { int pm, pn; };
struct Gemm { const bf16_t* A; const bf16_t* Bt; int M, N, K; };

struct StaticOrder {
    int nM, nN, nwg, G, c;
    __host__ __device__ void init(int M, int N, int G_, int c_) { nM = M / BM; nN = N / BM; nwg = nM * nN; G = G_; c = c_; }
    __host__ __device__ bool next(int i, Unit& u) const {
        const long L = (long)i * G + c; if (L >= nwg) return false;
        int wgid = (int)L; { const int q = nwg / NXCD, r = nwg % NXCD, xcd = wgid % NXCD, off = wgid / NXCD; wgid = (xcd < r ? xcd * (q + 1) : r * (q + 1) + (xcd - r) * q) + off; }
        const int nig = WGM * nN, gid = wgid / nig, fm = gid * WGM, gsz = (nM - fm) < WGM ? (nM - fm) : WGM;
        u.pm = fm + ((wgid % nig) % gsz); u.pn = (wgid % nig) / gsz; return true;
    }
    __device__ __forceinline__ void a_ready(const Unit&) const {}
    __device__ __forceinline__ void done(const Unit&) const {}
};
__device__ __forceinline__ unsigned cvt_pk_bf16(float lo, float hi) { unsigned r; asm volatile("v_cvt_pk_bf16_f32 %0, %1, %2" : "=v"(r) : "v"(lo), "v"(hi)); return r; }
typedef float f32x2 __attribute__((ext_vector_type(2)));
typedef unsigned u32x2 __attribute__((ext_vector_type(2)));
__device__ __forceinline__ float mul_sigmoid(float v, float z) { return v * __builtin_amdgcn_rcpf(1.0f + __builtin_amdgcn_exp2f(-1.4426950408889634f * z)); }
__device__ __forceinline__ float gelu_tanh(float v) { return mul_sigmoid(v, 1.5957691216057308f * (v + 0.044715f * v * v * v)); }
constexpr float ATT_C2 = 0.125f * 1.4426950408889634f;

struct EpiSwiGLU {
    static constexpr bool PERM = true, AFTER_DRAIN = false;
    bf16_t* O; int ldc; const float* ssq;
    __device__ __forceinline__ void operator()(const f32x4 (&acc)[2][2][4][2], const Unit& u, int wr, int wc, int fr, int fq) const {
        const int row0 = u.pm * BM + wr * 64 + fr; const int col0 = u.pn * 128 + wc * 32 + 8 * fq;
#pragma unroll
        for (int ai = 0; ai < 2; ++ai)
#pragma unroll
            for (int m = 0; m < 4; ++m) {
                bf16_t* p = O + (size_t)(row0 + ai * HALF + m * 16) * ldc + col0;
                const float rs = __builtin_amdgcn_rsqf(ssq[row0 + ai * HALF + m * 16] * (1.0f / 1024.0f) + 1e-6f);
                const f32x4 a0 = acc[ai][0][m][0] * rs, a1 = acc[ai][0][m][1] * rs, b0 = acc[ai][1][m][0] * rs, b1 = acc[ai][1][m][1] * rs;
                u32x4 w;
                w.x = cvt_pk_bf16(mul_sigmoid(a0[0], a0[0]) * b0[0], mul_sigmoid(a0[1], a0[1]) * b0[1]);
                w.y = cvt_pk_bf16(mul_sigmoid(a0[2], a0[2]) * b0[2], mul_sigmoid(a0[3], a0[3]) * b0[3]);
                w.z = cvt_pk_bf16(mul_sigmoid(a1[0], a1[0]) * b1[0], mul_sigmoid(a1[1], a1[1]) * b1[1]);
                w.w = cvt_pk_bf16(mul_sigmoid(a1[2], a1[2]) * b1[2], mul_sigmoid(a1[3], a1[3]) * b1[3]);
                *(u32x4*)p = w;
            }
    }
};
template <bool WXB> struct EpiRes {
    static constexpr bool PERM = true, AFTER_DRAIN = false;
    const float* xin; float* xout; bf16_t* xb; float* ssq; float s;
    __device__ __forceinline__ void operator()(const f32x4 (&acc)[2][2][4][2], const Unit& u, int wr, int wc, int fr, int fq) const {
        const int row0 = u.pm * BM + wr * 64 + fr; const int col0 = u.pn * BM + wc * 32 + 8 * fq;
#pragma unroll
        for (int ai = 0; ai < 2; ++ai)
#pragma unroll
            for (int m = 0; m < 4; ++m) {
                const int row = row0 + ai * HALF + m * 16; const size_t off = (size_t)row * 1024 + col0; float ss = 0.f;
#pragma unroll
                for (int bj = 0; bj < 2; ++bj) {
                    const f32x4 o0 = *(const f32x4*)(xin + off + bj * HALF) + acc[ai][bj][m][0] * s, o1 = *(const f32x4*)(xin + off + bj * HALF + 4) + acc[ai][bj][m][1] * s;
                    *(f32x4*)(xout + off + bj * HALF) = o0; *(f32x4*)(xout + off + bj * HALF + 4) = o1;
                    if (WXB) { u32x4 w; w.x = cvt_pk_bf16(o0[0], o0[1]); w.y = cvt_pk_bf16(o0[2], o0[3]); w.z = cvt_pk_bf16(o1[0], o1[1]); w.w = cvt_pk_bf16(o1[2], o1[3]); *(u32x4*)(xb + off + bj * HALF) = w;
                        ss += ((o0[0] * o0[0] + o0[1] * o0[1]) + (o0[2] * o0[2] + o0[3] * o0[3])) + ((o1[0] * o1[0] + o1[1] * o1[1]) + (o1[2] * o1[2] + o1[3] * o1[3])); }
                }
                if (WXB) { ss += __shfl_xor(ss, 16); ss += __shfl_xor(ss, 32); if (fq == 0) unsafeAtomicAdd(ssq + row, ss); }
            }
    }
};
template <int KIND> struct EpiProj {
    static constexpr bool PERM = true, AFTER_DRAIN = false;
    bf16_t* O; int ldc; const float* gq; const float* gk; const float* gm; const float* ssq;
    __device__ __forceinline__ void operator()(const f32x4 (&acc)[2][2][4][2], const Unit& u, int wr, int wc, int fr, int fq) const {
        int mode = 0; const float* g = gk; float sc = 1.f; const int pn = u.pn;
        if (KIND == 0) { if (pn < 3) { mode = 1; g = gq; sc = ATT_C2; } else if (pn < 6) { mode = 1; g = gk; } else if (pn < 9) { mode = 0; } else { mode = 1; g = gm; sc = ATT_C2; } }
        else if (KIND == 1) { if (pn < 3) { mode = 2; } else if (pn < 6) { mode = 3; g = gk + (4 * (pn - 3) + wc) * 64; } else { mode = 1; g = gm; sc = ATT_C2; } }
        else { if (pn == 0) { mode = 1; g = gk; } else { mode = 0; } }
        f32x4 gv[2][2];
#pragma unroll
        for (int bj = 0; bj < 2; ++bj)
#pragma unroll
            for (int n = 0; n < 2; ++n) gv[bj][n] = (mode & 1) ? *(const f32x4*)(g + 32 * bj + 8 * fq + 4 * n) * sc : (f32x4){1.f, 1.f, 1.f, 1.f};
        const int row0 = u.pm * BM + wr * 64 + fr; const int col0 = pn * BM + wc * 64 + 8 * fq;
#pragma unroll
        for (int ai = 0; ai < 2; ++ai)
#pragma unroll
            for (int m = 0; m < 4; ++m) {
                f32x4 v[2][2];
#pragma unroll
                for (int bj = 0; bj < 2; ++bj)
#pragma unroll
                    for (int n = 0; n < 2; ++n) v[bj][n] = acc[ai][bj][m][n];
                if (KIND != 2) { const float rs = __builtin_amdgcn_rsqf(ssq[row0 + ai * HALF + m * 16] * (1.0f / 1024.0f) + 1e-6f);
#pragma unroll
                    for (int bj = 0; bj < 2; ++bj)
#pragma unroll
                        for (int n = 0; n < 2; ++n) v[bj][n] = v[bj][n] * rs; }
                if (mode & 2) {
#pragma unroll
                    for (int bj = 0; bj < 2; ++bj)
#pragma unroll
                        for (int n = 0; n < 2; ++n)
#pragma unroll
                            for (int e = 0; e < 4; ++e) v[bj][n][e] = gelu_tanh(v[bj][n][e]);
                }
                if (mode & 1) {
                    float ss = 0.f;
#pragma unroll
                    for (int bj = 0; bj < 2; ++bj)
#pragma unroll
                        for (int n = 0; n < 2; ++n) { const f32x4 x = v[bj][n]; ss += (x[0] * x[0] + x[1] * x[1]) + (x[2] * x[2] + x[3] * x[3]); }
                    ss += __shfl_xor(ss, 16); ss += __shfl_xor(ss, 32);
                    const float r = __builtin_amdgcn_rsqf(ss * (1.0f / 64.0f) + 1e-6f);
#pragma unroll
                    for (int bj = 0; bj < 2; ++bj)
#pragma unroll
                        for (int n = 0; n < 2; ++n) v[bj][n] = v[bj][n] * r * gv[bj][n];
                }
                bf16_t* p = O + (size_t)(row0 + ai * HALF + m * 16) * ldc + col0;
#pragma unroll
                for (int bj = 0; bj < 2; ++bj) {
                    u32x4 w; w.x = cvt_pk_bf16(v[bj][0][0], v[bj][0][1]); w.y = cvt_pk_bf16(v[bj][0][2], v[bj][0][3]); w.z = cvt_pk_bf16(v[bj][1][0], v[bj][1][1]); w.w = cvt_pk_bf16(v[bj][1][2], v[bj][1][3]);
                    *(u32x4*)(p + 32 * bj) = w;
                }
            }
    }
};
template <class Epi, class Sched, bool ALIGN_EPI = false, bool SP2 = false>
__device__ __forceinline__ void gemm_phase(PG8_LAS unsigned char* lds, const Gemm g, const Sched& S, const Epi& E) {
    int tid_l = threadIdx.x; asm volatile("" : "+v"(tid_l));
    const int tid = tid_l, wid = __builtin_amdgcn_readfirstlane(tid >> 6), lane = tid & 63, wr = wid >> 2, wc = wid & 3, fr = lane & 15, fq = lane >> 4;
    const int K = g.K, nt = K / BK;
    unsigned voffA[2], voffB[2];
#pragma unroll
    for (int i = 0; i < 2; ++i) { int R, C; stage_rc(tid * 16 + i * 8192, R, C); const int Rb = Epi::PERM ? ((R & ~31) + perm32(R & 31)) : R;
        voffA[i] = (unsigned)(R * K + C) * 2u; voffB[i] = (unsigned)(Rb * K + C) * 2u; }
    const size_t kstep = (size_t)(BK * 2);
    const size_t hstep = (size_t)HALF * K * 2;
    const size_t tstep = 2 * hstep;
    const unsigned ldsw = (unsigned)wid * 1024u;
    const int aoff = lds_byte(wr * 64 + fr, fq * 8), boff = lds_byte(wc * 32 + fr, fq * 8);
#define PG8_SA(b, h) (((b) * 2 + (h)) * HTB)
#define PG8_SB(b, h) ((4 + (b) * 2 + (h)) * HTB)
#define PG8_STAGE(bufoff, gbase, voff) do { _Pragma("unroll") for (int _i = 0; _i < 2; ++_i) \
        __builtin_amdgcn_global_load_lds((const unsigned*)((const char*)(gbase) + (voff)[_i]), (PG8_LAS unsigned*)(lds + (bufoff) + ldsw + _i * 8192), 16, 0, 0); } while (0)
#define PG8_LDA(dst, b, h) do { _Pragma("unroll") for (int m = 0; m < 4; ++m) _Pragma("unroll") for (int k = 0; k < 2; ++k) dst[m][k] = *(const PG8_LAS bf16x8*)(lds + PG8_SA(b, h) + aoff + m * 2048 + k * 1024); } while (0)
#define PG8_LDB(dst, b, h) do { _Pragma("unroll") for (int n = 0; n < 2; ++n) _Pragma("unroll") for (int k = 0; k < 2; ++k) dst[n][k] = *(const PG8_LAS bf16x8*)(lds + PG8_SB(b, h) + boff + n * 2048 + k * 1024); } while (0)
#define PG8_MMA(ai, bj, At, Bt) do { __builtin_amdgcn_s_setprio(1); _Pragma("unroll") for (int m = 0; m < 4; ++m) _Pragma("unroll") for (int n = 0; n < 2; ++n) _Pragma("unroll") for (int k = 0; k < 2; ++k) \
        acc[ai][bj][m][n] = __builtin_amdgcn_mfma_f32_16x16x32_bf16(Bt[n][k], At[m][k], acc[ai][bj][m][n], 0, 0, 0); __builtin_amdgcn_s_setprio(0); } while (0)
#define PG8_WAIT_V(n) asm volatile("s_waitcnt vmcnt(" #n ")" ::: "memory")
#define PG8_WAIT_L(n) asm volatile("s_waitcnt lgkmcnt(" #n ")" ::: "memory")
#define PG8_BAR __builtin_amdgcn_s_barrier()
#define PG8_SCHED __builtin_amdgcn_sched_barrier(0)
    Unit cur, nxt; int ui = 0;
    if (!S.next(0, cur)) return;
    f32x4 acc[2][2][4][2];
#pragma unroll
    for (int a = 0; a < 2; ++a)
#pragma unroll
        for (int b = 0; b < 2; ++b)
#pragma unroll
            for (int m = 0; m < 4; ++m)
#pragma unroll
                for (int n = 0; n < 2; ++n) acc[a][b][m][n] = (f32x4){0.f, 0.f, 0.f, 0.f};
    bf16x8 At[4][2], B0[2][2], B1[2][2];
    const char* cA = (const char*)g.A + (size_t)cur.pm * tstep; const char* cB = (const char*)g.Bt + (size_t)cur.pn * tstep;
    S.a_ready(cur);
    if constexpr (SP2) {
        PG8_STAGE(PG8_SB(0, 0), cB, voffB); PG8_STAGE(PG8_SB(0, 1), cB + hstep, voffB); PG8_STAGE(PG8_SA(0, 0), cA, voffA); PG8_STAGE(PG8_SA(0, 1), cA + hstep, voffA);
        if (wr == 1) PG8_BAR;
        PG8_WAIT_V(2); PG8_BAR;
        PG8_STAGE(PG8_SB(1, 0), cB + kstep, voffB); PG8_STAGE(PG8_SA(1, 0), cA + kstep, voffA); PG8_STAGE(PG8_SB(1, 1), cB + hstep + kstep, voffB);
        PG8_WAIT_V(6); PG8_BAR;
    } else {
        PG8_STAGE(PG8_SB(0, 0), cB, voffB); PG8_STAGE(PG8_SA(0, 0), cA, voffA); PG8_STAGE(PG8_SB(0, 1), cB + hstep, voffB); PG8_STAGE(PG8_SA(0, 1), cA + hstep, voffA);
        if (wr == 1) PG8_BAR;
        PG8_WAIT_V(4); PG8_BAR;
        PG8_STAGE(PG8_SB(1, 0), cB + kstep, voffB); PG8_STAGE(PG8_SA(1, 0), cA + kstep, voffA); PG8_STAGE(PG8_SB(1, 1), cB + hstep + kstep, voffB);
        PG8_WAIT_V(6); PG8_BAR;
    }
    for (;;) {
        const bool has_next = S.next(ui + 1, nxt);
        const char* nA = has_next ? (const char*)g.A + (size_t)nxt.pm * tstep : cA; const char* nB = has_next ? (const char*)g.Bt + (size_t)nxt.pn * tstep : cB;
        for (int t = 0; t < nt; t += 2) {
            const bool last = (t == nt - 2);
            const char* a1 = cA + (size_t)(t + 1) * kstep;
            const char* a2 = last ? nA : cA + (size_t)(t + 2) * kstep; const char* b2 = last ? nB : cB + (size_t)(t + 2) * kstep;
            const char* a3 = a2 + kstep; const char* b3 = b2 + kstep;
            if (last && has_next) S.a_ready(nxt);
            if constexpr (SP2) {
            PG8_LDB(B0, 0, 0); PG8_LDB(B1, 0, 1); PG8_SCHED; PG8_LDA(At, 0, 0); PG8_STAGE(PG8_SA(1, 1), a1 + hstep, voffA);
            PG8_WAIT_V(8); PG8_WAIT_L(0); PG8_BAR; PG8_MMA(0, 0, At, B0); PG8_MMA(0, 1, At, B1); PG8_BAR; PG8_SCHED;
            PG8_LDA(At, 0, 1); PG8_STAGE(PG8_SB(0, 0), b2, voffB); PG8_STAGE(PG8_SB(0, 1), b2 + hstep, voffB); PG8_STAGE(PG8_SA(0, 0), a2, voffA);
            PG8_WAIT_V(8); PG8_WAIT_L(0); PG8_BAR; PG8_MMA(1, 0, At, B0); PG8_MMA(1, 1, At, B1); PG8_BAR; PG8_SCHED;
            PG8_LDB(B0, 1, 0); PG8_LDB(B1, 1, 1); PG8_SCHED; PG8_LDA(At, 1, 0); PG8_STAGE(PG8_SA(0, 1), a2 + hstep, voffA);
            PG8_WAIT_V(8); PG8_WAIT_L(0); PG8_BAR; PG8_MMA(0, 0, At, B0); PG8_MMA(0, 1, At, B1); PG8_BAR; PG8_SCHED;
            PG8_LDA(At, 1, 1); PG8_STAGE(PG8_SB(1, 0), b3, voffB); PG8_STAGE(PG8_SB(1, 1), b3 + hstep, voffB); PG8_STAGE(PG8_SA(1, 0), a3, voffA);
            PG8_WAIT_V(8); PG8_WAIT_L(0); PG8_BAR; PG8_MMA(1, 0, At, B0); PG8_MMA(1, 1, At, B1); PG8_BAR; PG8_SCHED;
            } else {
            PG8_LDB(B0, 0, 0); PG8_SCHED; PG8_LDA(At, 0, 0); PG8_STAGE(PG8_SA(1, 1), a1 + hstep, voffA);
            PG8_WAIT_L(8); PG8_BAR; PG8_WAIT_L(0); PG8_MMA(0, 0, At, B0); PG8_BAR; PG8_SCHED;
            PG8_LDB(B1, 0, 1); PG8_STAGE(PG8_SB(0, 0), b2, voffB);
            PG8_BAR; PG8_WAIT_L(0); PG8_MMA(0, 1, At, B1); PG8_BAR;
            PG8_LDA(At, 0, 1); PG8_STAGE(PG8_SA(0, 0), a2, voffA);
            PG8_BAR; PG8_WAIT_L(0); PG8_MMA(1, 0, At, B0); PG8_BAR; PG8_SCHED;
            PG8_STAGE(PG8_SB(0, 1), b2 + hstep, voffB);
            PG8_WAIT_V(6); PG8_BAR; PG8_MMA(1, 1, At, B1); PG8_BAR;
            PG8_LDB(B0, 1, 0); PG8_SCHED; PG8_LDA(At, 1, 0); PG8_STAGE(PG8_SA(0, 1), a2 + hstep, voffA);
            PG8_WAIT_L(8); PG8_BAR; PG8_WAIT_L(0); PG8_MMA(0, 0, At, B0); PG8_BAR; PG8_SCHED;
            PG8_LDB(B1, 1, 1); PG8_STAGE(PG8_SB(1, 0), b3, voffB);
            PG8_BAR; PG8_WAIT_L(0); PG8_MMA(0, 1, At, B1); PG8_BAR;
            PG8_LDA(At, 1, 1); PG8_STAGE(PG8_SA(1, 0), a3, voffA);
            PG8_BAR; PG8_WAIT_L(0); PG8_MMA(1, 0, At, B0); PG8_BAR; PG8_SCHED;
            PG8_STAGE(PG8_SB(1, 1), b3 + hstep, voffB);
            PG8_WAIT_V(6); PG8_BAR; PG8_MMA(1, 1, At, B1); PG8_BAR;
            }
        }
        if constexpr (ALIGN_EPI) { if (wr == 0) PG8_BAR; }
        if constexpr (!Epi::AFTER_DRAIN) { E(acc, cur, wr, wc, fr, fq); S.done(cur); }
        if (!has_next) break;
#pragma unroll
        for (int a = 0; a < 2; ++a)
#pragma unroll
            for (int b = 0; b < 2; ++b)
#pragma unroll
                for (int m = 0; m < 4; ++m)
#pragma unroll
                    for (int n = 0; n < 2; ++n) acc[a][b][m][n] = (f32x4){0.f, 0.f, 0.f, 0.f};
        cur = nxt; cA = nA; cB = nB; ++ui;
        if constexpr (ALIGN_EPI) { if (wr == 1) PG8_BAR; }
    }
    PG8_WAIT_V(0);
    if constexpr (!ALIGN_EPI) { if (wr == 0) PG8_BAR; }
    PG8_BAR;
    if constexpr (Epi::AFTER_DRAIN) { E.fused(acc, cur, wr, wc, fr, fq, lds, wid, lane); S.done(cur); }
#undef PG8_SA
#undef PG8_SB
#undef PG8_STAGE
#undef PG8_LDA
#undef PG8_LDB
#undef PG8_MMA
#undef PG8_WAIT_V
#undef PG8_WAIT_L
#undef PG8_BAR
#undef PG8_SCHED
}
}
#include <hip/hip_bf16.h>
#include <cmath>
namespace attn_body {
using bf16=__hip_bfloat16;
using bf16x8=__attribute__((ext_vector_type(8)))short;
using s16x4=__attribute__((ext_vector_type(4)))short;
using f32x16=__attribute__((ext_vector_type(16)))float;
using u32x4=__attribute__((ext_vector_type(4)))unsigned;
using f32x4v=__attribute__((ext_vector_type(4)))float;
constexpr int D=64;
constexpr int NW=8,QBLK=32,QB=QBLK*NW,KVBLK=64;
__device__ __forceinline__ int crow(int r,int hi){return (r&3)+8*(r>>2)+4*hi;}
#define SBAR() __builtin_amdgcn_sched_barrier(0)
__device__ __forceinline__ void cmask(f32x16&p0,f32x16&p1,int jb,int qrel,int hi){
  const float NEG=-INFINITY; int kb=64*jb+4*hi;
  #pragma unroll
  for(int r=0;r<16;++r){int kv=kb+(r&3)+8*(r>>2); if(kv>qrel)p0[r]=NEG; if(kv+32>qrel)p1[r]=NEG;}
}

constexpr int NSLOT=3, SLOTB=8192;
constexpr int LDS_K=0, LDS_V=NSLOT*SLOTB, LDS_WS=2*NSLOT*SLOTB, LDS_OST=LDS_WS+NW*64*4, LDS_BIAS=LDS_OST+NW*4096, LDS_BYTES=LDS_BIAS+32768;
constexpr float C2=0.125f*1.4426950408889634f;
__device__ __forceinline__ void glds16(const void*gsrc,unsigned lds_dst){unsigned keep;
  asm volatile("s_mov_b32 %0, m0\n\ts_mov_b32 m0, %2\n\ts_nop 0\n\tglobal_load_lds_dwordx4 %1, off\n\ts_mov_b32 m0, %0":"=&s"(keep):"v"(gsrc),"s"(lds_dst):"memory");}
__device__ __forceinline__ float max3f(float a,float b,float c){float r;asm("v_max3_f32 %0, %1, %2, %3":"=v"(r):"v"(a),"v"(b),"v"(c));return r;}
__device__ __forceinline__ float max2f(float a,float b){float r;asm("v_max_f32_e32 %0, %1, %2":"=v"(r):"v"(a),"v"(b));return r;}
__device__ __forceinline__ float fadd_s(float a,float b){float r;asm("v_add_f32_e32 %0, %1, %2":"=v"(r):"v"(a),"v"(b));return r;}
__device__ __forceinline__ float fsub_s(float a,float b){float r;asm("v_sub_f32_e32 %0, %1, %2":"=v"(r):"v"(a),"v"(b));return r;}
typedef float f32x2_t __attribute__((ext_vector_type(2))); typedef __bf16 bf16x2_t __attribute__((ext_vector_type(2)));
__device__ __forceinline__ unsigned cvtpk_s(float lo,float hi){f32x2_t v={lo,hi};bf16x2_t b=__builtin_convertvector(v,bf16x2_t);return __builtin_bit_cast(unsigned,b);}
#define WAIT_BAR(N) asm volatile("s_waitcnt vmcnt(" #N ") lgkmcnt(0)\n\ts_barrier":::"memory")

__device__ __forceinline__ void qkt(f32x16&p0,f32x16&p1,const char*Kslot,const bf16x8*qr,const f32x16&negm,int r32,int hi){
  const char*kb=Kslot+hi*1024+r32*16;
  #pragma unroll
  for(int d0=0;d0<4;++d0){
    const bf16x8 b0=*reinterpret_cast<const bf16x8*>(kb+d0*2048);
    const bf16x8 b1=*reinterpret_cast<const bf16x8*>(kb+d0*2048+512);
    if(d0==0){p0=__builtin_amdgcn_mfma_f32_32x32x16_bf16(b0,qr[0],negm,0,0,0);p1=__builtin_amdgcn_mfma_f32_32x32x16_bf16(b1,qr[0],negm,0,0,0);}
    else{p0=__builtin_amdgcn_mfma_f32_32x32x16_bf16(b0,qr[d0],p0,0,0,0);p1=__builtin_amdgcn_mfma_f32_32x32x16_bf16(b1,qr[d0],p1,0,0,0);}}
}
typedef __attribute__((address_space(3))) const char* lds_cptr;
typedef short v4i16_t __attribute__((ext_vector_type(4)));
__device__ __forceinline__ void kload8(bf16x8*kf,lds_cptr kp){
  kf[0]=*(const __attribute__((address_space(3))) bf16x8*)(kp);      kf[1]=*(const __attribute__((address_space(3))) bf16x8*)(kp+512);
  kf[2]=*(const __attribute__((address_space(3))) bf16x8*)(kp+2048); kf[3]=*(const __attribute__((address_space(3))) bf16x8*)(kp+2560);
  kf[4]=*(const __attribute__((address_space(3))) bf16x8*)(kp+4096); kf[5]=*(const __attribute__((address_space(3))) bf16x8*)(kp+4608);
  kf[6]=*(const __attribute__((address_space(3))) bf16x8*)(kp+6144); kf[7]=*(const __attribute__((address_space(3))) bf16x8*)(kp+6656);
}
__device__ __forceinline__ void kload2(bf16x8*kf,lds_cptr kp,int j){ kf[2*j]=*(const __attribute__((address_space(3))) bf16x8*)(kp+j*2048); kf[2*j+1]=*(const __attribute__((address_space(3))) bf16x8*)(kp+j*2048+512); }
__device__ __forceinline__ s16x4 vtr(lds_cptr p){ return __builtin_bit_cast(s16x4,__builtin_amdgcn_ds_read_tr16_b64_v4i16((__attribute__((address_space(3))) v4i16_t*)p)); }
__device__ __forceinline__ float rowmax(const f32x16&p0,const f32x16&p1){
  float a=max3f(p0[0],p0[1],p1[0]),b=max3f(p0[2],p0[3],p1[1]);a=max3f(a,p1[2],p1[3]);
  #pragma unroll
  for(int r=4;r<16;r+=4){a=max3f(a,p0[r],p0[r+1]);b=max3f(b,p0[r+2],p0[r+3]);a=max3f(a,p1[r],p1[r+1]);b=max3f(b,p1[r+2],p1[r+3]);}
  const float m=max2f(a,b);
  auto rr=__builtin_amdgcn_permlane32_swap(__float_as_uint(m),__float_as_uint(m),false,false);
  return max2f(__uint_as_float(rr[0]),__uint_as_float(rr[1]));
}
__device__ __forceinline__ void pv(f32x16*o,int vb,bf16x8 pa0,bf16x8 pa1,bf16x8 pa2,bf16x8 pa3){
  #pragma unroll
  for(int d0=0;d0<2;++d0){s16x4 lo[4],hi[4];
    #pragma unroll
    for(int ks=0;ks<4;++ks){
      asm volatile("ds_read_b64_tr_b16 %0,%1 offset:%c2":"=&v"(lo[ks]):"v"(vb),"i"(d0*4096+ks*1024):"memory");
      asm volatile("ds_read_b64_tr_b16 %0,%1 offset:%c2":"=&v"(hi[ks]):"v"(vb),"i"(d0*4096+ks*1024+512):"memory");}
    asm volatile("s_waitcnt lgkmcnt(0)":::"memory");SBAR();
    #define PK(k) (bf16x8){lo[k][0],lo[k][1],lo[k][2],lo[k][3],hi[k][0],hi[k][1],hi[k][2],hi[k][3]}
    o[d0]=__builtin_amdgcn_mfma_f32_32x32x16_bf16(pa0,PK(0),o[d0],0,0,0);
    o[d0]=__builtin_amdgcn_mfma_f32_32x32x16_bf16(pa1,PK(1),o[d0],0,0,0);
    o[d0]=__builtin_amdgcn_mfma_f32_32x32x16_bf16(pa2,PK(2),o[d0],0,0,0);
    o[d0]=__builtin_amdgcn_mfma_f32_32x32x16_bf16(pa3,PK(3),o[d0],0,0,0);
    #undef PK
  }
}

#ifndef ATTN_STORE16
#define ATTN_STORE16(p,v) (*(u32x4*)(p)=(v))
#endif
template<int THRL,bool CAUSAL,bool BIAS,bool FIXED,int KP,int OP> __device__ __forceinline__ void attn_unit(const bf16*Qb,const int QP,const bf16*__restrict__ Kh,const bf16*__restrict__ Vh,bf16*Ob,const int NT_,const float*__restrict__ biasg,const float*__restrict__ biasq,const float bound,char*shm){
  int tid_l=threadIdx.x; asm volatile("":"+v"(tid_l)); const int tid=tid_l,lane=tid&63,r32=lane&31,hi=lane>>5; const int wid=__builtin_amdgcn_readfirstlane(tid>>6);
  const bf16*Qw=Qb+(long)(wid*QBLK)*QP;
  const lds_cptr shm3=(lds_cptr)shm;
  const unsigned lds0=(unsigned)(uintptr_t)shm;
  float*wsf=(float*)(shm+LDS_WS)+wid*64;
  const bf16*ksrc=Kh+(long)lane*KP+wid*8;
  const bf16*vsrc=Vh+(long)(16*(wid&3)+(lane>>2))*KP+(wid>>2)*32+(lane&3)*8;
  const unsigned kdst=lds0+LDS_K+wid*1024, vdst=lds0+LDS_V+wid*1024;
  #define DMA_K(t,slot) glds16(ksrc+(long)(t)*KVBLK*KP,(unsigned)__builtin_amdgcn_readfirstlane(kdst+(slot)))
  #define DMA_V(t,slot) glds16(vsrc+(long)(t)*KVBLK*KP,(unsigned)__builtin_amdgcn_readfirstlane(vdst+(slot)))
  const int vb0=(int)(lds0+LDS_V)+((lane>>4)&1)*32+(lane&3)*8+(4*hi+((lane&15)>>2))*64;
  const char*Kbase=shm+LDS_K; bf16x8 kf[8];
  const lds_cptr kp0=shm3+LDS_K+hi*1024+r32*16; const lds_cptr vp0=shm3+LDS_V+((lane>>4)&1)*32+(lane&3)*8+(4*hi+((lane&15)>>2))*64;
  const int NT=NT_;
  typedef __attribute__((address_space(3))) f32x4v* lds_f4p;
  if(BIAS){ const lds_f4p bl=(lds_f4p)(shm3+LDS_BIAS); const int n4=NT*16; for(int i=tid;i<n4;i+=NW*64){ bl[i]=((const f32x4v*)biasg)[i]; } }
  #define BIASADD(P0,P1,t) do{ if(BIAS){ const __attribute__((address_space(3))) f32x4v* bp_=(const __attribute__((address_space(3))) f32x4v*)(shm3+LDS_BIAS+(hi<<4))+(t)*16; \
    const float sub_=FIXED?refq:mhat; const f32x2_t s2_={sub_,sub_}; \
    _Pragma("unroll") for(int j_=0;j_<4;++j_){ const f32x4v b0_=bp_[2*j_], b1_=bp_[8+2*j_]; \
      const f32x2_t a0_=(f32x2_t){b0_[0],b0_[1]}-s2_, a1_=(f32x2_t){b0_[2],b0_[3]}-s2_, c0_=(f32x2_t){b1_[0],b1_[1]}-s2_, c1_=(f32x2_t){b1_[2],b1_[3]}-s2_; \
      const f32x2_t p0_=(f32x2_t){P0[4*j_],P0[4*j_+1]}+a0_, p1_=(f32x2_t){P0[4*j_+2],P0[4*j_+3]}+a1_, q0_=(f32x2_t){P1[4*j_],P1[4*j_+1]}+c0_, q1_=(f32x2_t){P1[4*j_+2],P1[4*j_+3]}+c1_; \
      P0[4*j_]=p0_[0];P0[4*j_+1]=p0_[1];P0[4*j_+2]=p1_[0];P0[4*j_+3]=p1_[1]; P1[4*j_]=q0_[0];P1[4*j_+1]=q0_[1];P1[4*j_+2]=q1_[0];P1[4*j_+3]=q1_[1]; } } }while(0)
  DMA_K(0,0);DMA_V(0,0);DMA_K(1,SLOTB);
  bf16x8 qr[4];
  #pragma unroll
  for(int d0=0;d0<4;++d0)qr[d0]=*reinterpret_cast<const bf16x8*>(&Qw[(long)r32*QP+d0*16+hi*8]);
  float mhat=0.f,l_reg=0.f;f32x16 o[2];f32x16 negm; { float z0_; asm volatile("v_mov_b32 %0, 0":"=v"(z0_)); _Pragma("unroll") for(int r=0;r<16;++r){o[0][r]=z0_;o[1][r]=z0_;negm[r]=z0_;} } float refq=0.f; if(FIXED){ refq=biasq[wid*QBLK+r32]+bound; } if(!BIAS)asm volatile("":"+v"(negm));
  const int qrel=wid*QBLK+r32;
  #define CMASK(P0,P1,t) do{ if(CAUSAL){int jb_=(t)-(NT-4); if(jb_>=0)cmask(P0,P1,jb_,qrel,hi);} }while(0)
  bool resc=false;
  #define START(P0,P1) do{ resc=false; \
    if(!FIXED){ const float rm=rowmax(P0,P1); const float dl=rm; mhat=fadd_s(mhat,dl); \
      _Pragma("unroll") for(int r=0;r<16;++r){P0[r]=fsub_s(P0[r],dl);P1[r]=fsub_s(P1[r],dl);} \
      if(!BIAS){ _Pragma("unroll") for(int r=0;r<16;++r)negm[r]=-mhat; asm volatile("":"+v"(negm)); } } \
    _Pragma("unroll") for(int r=0;r<16;++r)P0[r]=__builtin_amdgcn_exp2f(P0[r]); }while(0)
  #define RESC() do{ if(!FIXED&&resc){ asm volatile("s_waitcnt lgkmcnt(0)":::"memory"); \
      _Pragma("unroll") for(int d_=0;d_<2;++d_) _Pragma("unroll") for(int r=0;r<16;++r)o[d_][r]*=wsf[crow(r,hi)]; } }while(0)
  f32x16 pA0,pA1,pB0,pB1;
  int sl_prev=0,sl_cur=0,sl_next=SLOTB;
  #define ROT() do{sl_prev=sl_cur;sl_cur=sl_next;sl_next=(sl_next==(NSLOT-1)*SLOTB)?0:sl_next+SLOTB;}while(0)
  DMA_K(2,2*SLOTB);
  WAIT_BAR(3);
  if(BIAS){qkt(pA0,pA1,Kbase,qr,f32x16{},r32,hi);}else{qkt(pA0,pA1,Kbase,qr,negm,r32,hi);}asm volatile("s_nop 15\n\ts_nop 7":"+v"(pA0),"+v"(pA1));BIASADD(pA0,pA1,0);CMASK(pA0,pA1,0);
  START(pA0,pA1);
  _Pragma("unroll") for(int r=0;r<16;++r)pA1[r]=__builtin_amdgcn_exp2f(pA1[r]);
  WAIT_BAR(0);
  DMA_K(3,0);DMA_V(1,SLOTB);
  ROT();
  kload8(kf,kp0+sl_cur);
  WAIT_BAR(2);
  s16x4 vlo[8],vhi[8]; u32x4 pw0,pw1,pw2,pw3;
  #define PKW(P,B) cvtpk_s(P[B],P[B+1])
  #define PAF(k) __builtin_bit_cast(bf16x8,pw##k)
  #define VFR(i) (bf16x8){vlo[i][0],vlo[i][1],vlo[i][2],vlo[i][3],vhi[i][0],vhi[i][1],vhi[i][2],vhi[i][3]}
  #define PIN(x) asm volatile("":"+v"(x))
  #define MX3(a,b,c) __builtin_fmaxf(__builtin_fmaxf((a),(b)),(c))
  #define GAPA(MF,A0,A1,A2,A3,W0,W1,PW) do{ MF; sacc+=A0; sacc+=A1; sacc+=A2; sacc+=A3; PIN(sacc); W0; W1; PIN(PW); SBAR(); }while(0)
  #define EX(v) __builtin_amdgcn_exp2f(v)
  #define GAPB(MF,X,B) do{ MF; X[B]=EX(X[B]); X[B+1]=EX(X[B+1]); X[B+2]=EX(X[B+2]); X[B+3]=EX(X[B+3]); PIN(X); SBAR(); }while(0)
  #define VRD(i) do{ vlo[i]=vtr(vp_+(((i)>>2)*4096+((i)&3)*1024)); vhi[i]=vtr(vp_+(((i)>>2)*4096+((i)&3)*1024+512)); }while(0)
  #define KRD(G,j) do{ if(G){ kload2(kf,kp0+sl_next,j); SBAR(); } }while(0)
  #define STEP(C0,C1,P0,P1,t,GK,GV,GL) do{ SBAR(); \
    const lds_cptr vp_=vp0+sl_prev; \
    VRD(0); SBAR(); float sacc=(P0[0]+P0[1]); \
    GAPA(C0=(BIAS?__builtin_amdgcn_mfma_f32_32x32x16_bf16(kf[0],qr[0],f32x16{},0,0,0):__builtin_amdgcn_mfma_f32_32x32x16_bf16(kf[0],qr[0],negm,0,0,0)), P0[2],P0[3],P0[4],P0[5],     pw0[0]=PKW(P0,0), pw0[1]=PKW(P0,2), pw0); \
    VRD(4); SBAR(); GAPA(C1=(BIAS?__builtin_amdgcn_mfma_f32_32x32x16_bf16(kf[1],qr[0],f32x16{},0,0,0):__builtin_amdgcn_mfma_f32_32x32x16_bf16(kf[1],qr[0],negm,0,0,0)), P0[6],P0[7],P0[8],P0[9],     pw0[2]=PKW(P0,4), pw0[3]=PKW(P0,6), pw0); \
    VRD(1); SBAR(); GAPA(C0=__builtin_amdgcn_mfma_f32_32x32x16_bf16(kf[2],qr[1],C0,0,0,0),   P0[10],P0[11],P0[12],P0[13], pw1[0]=PKW(P0,8), pw1[1]=PKW(P0,10), pw1); \
    VRD(5); SBAR(); GAPA(C1=__builtin_amdgcn_mfma_f32_32x32x16_bf16(kf[3],qr[1],C1,0,0,0),   P0[14],P0[15],P1[0],P1[1],   pw1[2]=PKW(P0,12),pw1[3]=PKW(P0,14), pw1); \
    VRD(2); SBAR(); GAPA(C0=__builtin_amdgcn_mfma_f32_32x32x16_bf16(kf[4],qr[2],C0,0,0,0),   P1[2],P1[3],P1[4],P1[5],     pw2[0]=PKW(P1,0), pw2[1]=PKW(P1,2), pw2); \
    VRD(6); SBAR(); GAPA(C1=__builtin_amdgcn_mfma_f32_32x32x16_bf16(kf[5],qr[2],C1,0,0,0),   P1[6],P1[7],P1[8],P1[9],     pw2[2]=PKW(P1,4), pw2[3]=PKW(P1,6), pw2); \
    VRD(3); SBAR(); GAPA(C0=__builtin_amdgcn_mfma_f32_32x32x16_bf16(kf[6],qr[3],C0,0,0,0),   P1[10],P1[11],P1[12],P1[13], pw3[0]=PKW(P1,8), pw3[1]=PKW(P1,10), pw3); \
    VRD(7); SBAR(); GAPA(C1=__builtin_amdgcn_mfma_f32_32x32x16_bf16(kf[7],qr[3],C1,0,0,0),   P1[14],P1[15],0.f,0.f,       pw3[2]=PKW(P1,12),pw3[3]=PKW(P1,14), pw3); \
    l_reg+=sacc; \
    if(GK){DMA_K((t)+3,sl_cur);} if(GV){DMA_V((t)+1,sl_next);} \
    BIASADD(C0,C1,t); CMASK(C0,C1,t); \
    if(!FIXED){ float a=MX3(C0[0],C0[1],C1[0]),b=MX3(C0[2],C0[3],C1[1]); a=MX3(a,C1[2],C1[3]); \
      _Pragma("unroll") for(int r=4;r<16;r+=4){a=MX3(a,C0[r],C0[r+1]);b=MX3(b,C0[r+2],C0[r+3]);a=MX3(a,C1[r],C1[r+1]);b=MX3(b,C1[r+2],C1[r+3]);} \
      float rm=__builtin_fmaxf(a,b); { auto rr=__builtin_amdgcn_permlane32_swap(__float_as_uint(rm),__float_as_uint(rm),false,false); rm=__builtin_fmaxf(__uint_as_float(rr[0]),__uint_as_float(rr[1])); } \
      resc=false; \
      if(__builtin_expect(__any(rm>(float)THRL),0)){ const float dl=__builtin_fmaxf(rm,0.f); mhat+=dl; \
        _Pragma("unroll") for(int r=0;r<16;++r){C0[r]-=dl;C1[r]-=dl;} \
        if(!BIAS){ _Pragma("unroll") for(int r=0;r<16;++r)negm[r]=-mhat; asm volatile("":"+v"(negm)); } \
        const float f=__builtin_amdgcn_exp2f(-dl); l_reg*=f; if(hi==0)wsf[r32]=f; resc=true; } } \
    SBAR(); \
    GAPB(o[0]=__builtin_amdgcn_mfma_f32_32x32x16_bf16(PAF(0),VFR(0),o[0],0,0,0), C0,0); \
    GAPB(o[1]=__builtin_amdgcn_mfma_f32_32x32x16_bf16(PAF(0),VFR(4),o[1],0,0,0), C0,4); \
    KRD(GL,0); GAPB(o[0]=__builtin_amdgcn_mfma_f32_32x32x16_bf16(PAF(1),VFR(1),o[0],0,0,0), C0,8); \
    KRD(GL,1); GAPB(o[1]=__builtin_amdgcn_mfma_f32_32x32x16_bf16(PAF(1),VFR(5),o[1],0,0,0), C0,12); \
    KRD(GL,2); GAPB(o[0]=__builtin_amdgcn_mfma_f32_32x32x16_bf16(PAF(2),VFR(2),o[0],0,0,0), C1,0); \
    KRD(GL,3); GAPB(o[1]=__builtin_amdgcn_mfma_f32_32x32x16_bf16(PAF(2),VFR(6),o[1],0,0,0), C1,4); \
    GAPB(o[0]=__builtin_amdgcn_mfma_f32_32x32x16_bf16(PAF(3),VFR(3),o[0],0,0,0), C1,8); \
    GAPB(o[1]=__builtin_amdgcn_mfma_f32_32x32x16_bf16(PAF(3),VFR(7),o[1],0,0,0), C1,12); \
    }while(0)
  int t=1;
  #undef CMASK
  #define CMASK(P0,P1,t) do{}while(0)
  for(;t+5<NT;t+=2){
    STEP(pB0,pB1,pA0,pA1,t,true,true,true);     WAIT_BAR(2); RESC(); ROT();
    STEP(pA0,pA1,pB0,pB1,t+1,true,true,true);   WAIT_BAR(2); RESC(); ROT();
  }
  #undef CMASK
  #define CMASK(P0,P1,t) do{ if(CAUSAL){int jb_=(t)-(NT-4); if(jb_>=0)cmask(P0,P1,jb_,qrel,hi);} }while(0)
  #define ENDW(tt) do{ if((tt)+3<NT){WAIT_BAR(2);} else if((tt)+2<NT){WAIT_BAR(1);} else {WAIT_BAR(0);} }while(0)
  for(;t+1<NT;t+=2){
    STEP(pB0,pB1,pA0,pA1,t,(t+3<NT),(t+1<NT),(t+1<NT));       ENDW(t);   RESC(); ROT();
    STEP(pA0,pA1,pB0,pB1,t+1,(t+4<NT),(t+2<NT),(t+2<NT));     ENDW(t+1); RESC(); ROT();
  }
  STEP(pB0,pB1,pA0,pA1,NT-1,false,false,false); RESC();
  { float sacc=pB0[0]+pB0[1]; _Pragma("unroll") for(int r=2;r<16;++r)sacc+=pB0[r]; _Pragma("unroll") for(int r=0;r<16;++r)sacc+=pB1[r]; l_reg+=sacc;
    pw0=(u32x4){PKW(pB0,0),PKW(pB0,2),PKW(pB0,4),PKW(pB0,6)};pw1=(u32x4){PKW(pB0,8),PKW(pB0,10),PKW(pB0,12),PKW(pB0,14)};pw2=(u32x4){PKW(pB1,0),PKW(pB1,2),PKW(pB1,4),PKW(pB1,6)};pw3=(u32x4){PKW(pB1,8),PKW(pB1,10),PKW(pB1,12),PKW(pB1,14)};
    SBAR(); pv(o,vb0+sl_cur,PAF(0),PAF(1),PAF(2),PAF(3)); }
  #undef PKW
  #undef PAF
  #undef VFR
  #undef PIN
  #undef MX3
  #undef GAPA
  #undef GAPB
  #undef EX
  #undef VRD
  #undef KRD
  #undef STEP
  #undef ENDW
  int tid_e=threadIdx.x; asm volatile("":"+v"(tid_e)); const int lane_e=tid_e&63,r32_e=lane_e&31,hi_e=lane_e>>5; float*wsf_e=(float*)(shm+LDS_WS)+wid*64;
  {auto rr=__builtin_amdgcn_permlane32_swap(__float_as_uint(l_reg),__float_as_uint(l_reg),false,false);l_reg=__uint_as_float(rr[0])+__uint_as_float(rr[1]);}
  if(hi_e==0)wsf_e[32+r32_e]=l_reg;asm volatile("s_waitcnt lgkmcnt(0)":::"memory");
  float rli[16];
  #pragma unroll
  for(int r=0;r<16;++r)rli[r]=__builtin_amdgcn_rcpf(wsf_e[32+crow(r,hi_e)]);
  bf16*Ow=Ob+(long)(wid*QBLK)*OP;
  { bf16*stg=(bf16*)(shm+LDS_OST)+wid*2048;
    #pragma unroll
    for(int r=0;r<16;++r){const int orow=crow(r,hi_e);
      #pragma unroll
      for(int d0=0;d0<2;++d0)stg[orow*64+d0*32+r32_e]=__float2bfloat16(o[d0][r]*rli[r]);}
    asm volatile("s_waitcnt lgkmcnt(0)":::"memory");
    #pragma unroll
    for(int i=0;i<4;++i){const int row=i*8+(lane_e>>3),ch=lane_e&7; const u32x4 v=*(const u32x4*)(stg+row*64+ch*8); ATTN_STORE16(Ow+(long)row*OP+ch*8,v);} }
  asm volatile("s_waitcnt lgkmcnt(0)\n\ts_barrier":::"memory");
  #undef DMA_K
  #undef DMA_V
  #undef CMASK
  #undef BIASADD
  #undef START
  #undef RESC
  #undef ROT
}
constexpr int ATTN_LDS_BYTES=LDS_BYTES;
#undef SBAR
#undef WAIT_BAR
}
#define GAS __attribute__((address_space(1)))
#define LAS __attribute__((address_space(3)))
typedef unsigned short bf16;
typedef unsigned v4u __attribute__((ext_vector_type(4)));
typedef unsigned v2u __attribute__((ext_vector_type(2)));
typedef float f32x4 __attribute__((ext_vector_type(4)));
typedef short bf16x8 __attribute__((ext_vector_type(8)));
typedef float f32x16 __attribute__((ext_vector_type(16)));
#define LDS_WAIT() asm volatile("s_waitcnt lgkmcnt(0)" ::: "memory")

constexpr int NWAVES = 8;
constexpr int M = 32768, DM = 1024, FF = 2816, SEQ = 8192, NBATCH = 4, MEML = 256;
constexpr int NFOX = 2560, NFOX_SRC = 2572, NGM = 1792;
constexpr float EPS = 1e-6f;
constexpr size_t MiB = 1u << 20;
constexpr size_t WS_WFI = 1 * MiB;
constexpr size_t WS_WFO = 45 * MiB;
constexpr size_t WS_WFOX = 67 * MiB;
constexpr size_t WS_WGM = 72 * MiB;
constexpr size_t WS_WOUT = 76 * MiB;
constexpr size_t WS_WMKV = 80 * MiB;
constexpr size_t WS_WSB = 82 * MiB;
constexpr size_t WS_MEMN = 83 * MiB;
constexpr size_t WS_KVM = 85 * MiB;
constexpr size_t WS_LOGF = 87 * MiB;
constexpr size_t WS_BIAS = 89 * MiB;
constexpr size_t WS_SSQ = 91 * MiB;
constexpr size_t WS_XN = 96 * MiB;
constexpr size_t WS_CAT = 160 * MiB;
constexpr size_t WS_G = 224 * MiB;
constexpr size_t WS_END = 400 * MiB;
constexpr int LDS_BYTES = 132096;

__device__ __forceinline__ unsigned f2bf(float f) { unsigned u = __builtin_bit_cast(unsigned, f); return (u + 0x7fffu + ((u >> 16) & 1u)) >> 16; }
__device__ __forceinline__ unsigned pk2(float lo, float hi) { return f2bf(lo) | (f2bf(hi) << 16); }
__device__ __forceinline__ float bf2f(unsigned short b) { return __builtin_bit_cast(float, (unsigned)b << 16); }
__device__ __forceinline__ float wave_sum(float v) {
#pragma unroll
    for (int o = 1; o < 64; o <<= 1) v += __shfl_xor(v, o);
    return v;
}

__device__ __forceinline__ void conv_item(const float* W, int K, int Nsrc, int sc0, bf16* WTrow0, int k0, LAS float* scr, int lane, const float* gain = nullptr) {
    {
        f32x4 w[8]; const int c4 = lane & 7;
#pragma unroll
        for (int i = 0; i < 8; ++i) w[i] = *(const f32x4*)(W + (size_t)(k0 + 8 * i + (lane >> 3)) * Nsrc + sc0 + 4 * c4);
#pragma unroll
        for (int i = 0; i < 8; ++i) { const int kk = 8 * i + (lane >> 3); const float gk = gain ? gain[k0 + kk] : 1.0f; LAS float* d = scr + kk * 33 + 4 * c4;
            d[0] = w[i].x * gk; d[1] = w[i].y * gk; d[2] = w[i].z * gk; d[3] = w[i].w * gk; }
    }
    LDS_WAIT(); asm volatile("" ::: "memory");
    const int c = lane & 7;
#pragma unroll
    for (int j = 0; j < 4; ++j) { const int n = (lane >> 3) + 8 * j; const LAS float* s = scr + (8 * c) * 33 + n;
        v4u o; o.x = pk2(s[0 * 33], s[1 * 33]); o.y = pk2(s[2 * 33], s[3 * 33]); o.z = pk2(s[4 * 33], s[5 * 33]); o.w = pk2(s[6 * 33], s[7 * 33]);
        *(v4u*)(WTrow0 + (size_t)n * K + k0 + 8 * c) = o; }
    LDS_WAIT(); asm volatile("" ::: "memory");
}
__device__ __forceinline__ int map_plain(int n0) { return n0; }
__device__ __forceinline__ int map_swiglu(int n0) { const int t = n0 >> 8, j = n0 & 255; return (j < 128) ? 128 * t + j : FF + 128 * t + (j - 128); }
__device__ __forceinline__ int map_head(int n0, int gap_tile, int gap) { const int t = n0 >> 8, p = n0 & 255, bj = p >> 7, wc = (p >> 5) & 3; return 256 * t + 64 * wc + 32 * bj + (t >= gap_tile ? gap : 0); }

struct Args { const float* in[22]; float* out; unsigned char* ws; };

__device__ __forceinline__ void norm_row(const float* xrow, const f32x4 (&gn)[4], bf16* orow, int lane, f32x4 (&v)[4]) {
    const f32x4* xr = (const f32x4*)xrow + lane; float s = 0.f;
#pragma unroll
    for (int j = 0; j < 4; ++j) { v[j] = xr[64 * j]; s += (v[j].x * v[j].x + v[j].y * v[j].y) + (v[j].z * v[j].z + v[j].w * v[j].w); }
    const float rstd = 1.0f / sqrtf(wave_sum(s) * (1.f / DM) + EPS);
    unsigned long long* o8 = (unsigned long long*)orow + lane;
#pragma unroll
    for (int j = 0; j < 4; ++j) { v[j] = v[j] * rstd * gn[j]; o8[64 * j] = (unsigned long long)pk2(v[j].x, v[j].y) | ((unsigned long long)pk2(v[j].z, v[j].w) << 32); }
}

__device__ __forceinline__ void gmlp_unit(int rc, int g, const bf16* PROJ, const bf16* WSB, const float* bs, bf16* CAT, LAS unsigned char* lds, int tid_in) {
    int tid = tid_in; asm volatile("" : "+v"(tid));
    const int lane = tid & 63, wid = tid >> 6, r32 = lane & 31, hi = lane >> 5;
    LAS bf16* VT = (LAS bf16*)lds;
    {
        const int row = tid >> 2, seg = tid & 3;
        const bf16* src = PROJ + (size_t)(rc * 128 + row) * NGM + 768 + g * 64 + seg * 16;
        const bf16x8 a = *(const bf16x8*)src, b = *(const bf16x8*)(src + 8);
#pragma unroll
        for (int e = 0; e < 8; ++e) { VT[(seg * 16 + e) * 136 + row] = (bf16)a[e]; VT[(seg * 16 + 8 + e) * 136 + row] = (bf16)b[e]; }
    }
    __syncthreads();
    const int tb = wid & 3, db = wid >> 2;
    f32x16 acc; { float z0_; asm volatile("v_mov_b32 %0, 0" : "=v"(z0_));
#pragma unroll
      for (int r = 0; r < 16; ++r) acc[r] = z0_; }
    const bf16* wrow = WSB + ((size_t)g * 128 + tb * 32 + r32) * 128 + 8 * hi;
    const LAS bf16* vrow = VT + (db * 32 + r32) * 136 + 8 * hi;
    const int nks = 2 * (tb + 1);
    for (int ks = 0; ks < nks; ++ks) {
        const bf16x8 A = *(const LAS bf16x8*)(vrow + 16 * ks); const bf16x8 Bf = *(const bf16x8*)(wrow + 16 * ks);
        acc = __builtin_amdgcn_mfma_f32_32x32x16_bf16(A, Bf, acc, 0, 0, 0);
    }
    const int t = tb * 32 + r32; const float bsv = bs[g * 128 + t];
    const size_t row = (size_t)rc * 128 + t;
    const bf16* up = PROJ + row * NGM + g * 64 + db * 32 + 4 * hi;
    bf16* op = CAT + row * DM + g * 64 + db * 32 + 4 * hi;
#pragma unroll
    for (int q = 0; q < 4; ++q) {
        const v2u uv = *(const v2u*)(up + 8 * q);
        const float u0 = __builtin_bit_cast(float, uv.x << 16), u1 = __builtin_bit_cast(float, uv.x & 0xffff0000u), u2 = __builtin_bit_cast(float, uv.y << 16), u3 = __builtin_bit_cast(float, uv.y & 0xffff0000u);
        v2u o; o.x = pk2(u0 * (acc[4 * q] + bsv), u1 * (acc[4 * q + 1] + bsv)); o.y = pk2(u2 * (acc[4 * q + 2] + bsv), u3 * (acc[4 * q + 3] + bsv));
        *(v2u*)(op + 8 * q) = o;
    }
    __syncthreads();
}

#define CW_XCNT(j) (128 + 64 * (j))
#define CW_XSUB(j) (128 + 64 * 16 + 64 * (j))
#define CW_TOP (128 + 64 * 32)
constexpr int CTL_BYTES = 16384;
__device__ __forceinline__ unsigned xcc_id() { return (unsigned)__builtin_amdgcn_s_getreg((3 << 11) | 20) & 0xFu; }
__device__ __forceinline__ void grid_bar(unsigned* ctl, volatile LAS unsigned* st, unsigned k, unsigned G) {
    asm volatile("s_waitcnt vmcnt(0)" ::: "memory");
    __syncthreads();
    int t = threadIdx.x; asm volatile("" : "+v"(t));
    if (t == 0) {
        const unsigned x = st[0], nloc = st[1];
        const unsigned old = __hip_atomic_fetch_add(ctl + CW_XSUB(x), 1u, __ATOMIC_RELAXED, __HIP_MEMORY_SCOPE_AGENT);
        if (old + 1u == k * nloc) {
            __builtin_amdgcn_fence(__ATOMIC_RELEASE, "agent");
            asm volatile("s_waitcnt vmcnt(0)" ::: "memory");
            __hip_atomic_fetch_add(ctl + CW_TOP, nloc, __ATOMIC_RELAXED, __HIP_MEMORY_SCOPE_AGENT);
        }
        while (__hip_atomic_load(ctl + CW_TOP, __ATOMIC_RELAXED, __HIP_MEMORY_SCOPE_AGENT) < k * G) __builtin_amdgcn_s_sleep(2);
        __builtin_amdgcn_fence(__ATOMIC_ACQUIRE, "agent");
        asm volatile("s_waitcnt vmcnt(0)" ::: "memory");
    }
    __syncthreads();
}
__global__ void __launch_bounds__(NWAVES * 64, 2) fwd_megakernel(Args args) {
    extern __shared__ __attribute__((aligned(16))) unsigned char lds[];
    cg::grid_group grid = cg::this_grid();
    LAS unsigned char* ldsl = (LAS unsigned char*)lds;
    const int tid = threadIdx.x, lane = tid & 63, wave = __builtin_amdgcn_readfirstlane(tid >> 6);
    const int G = gridDim.x, bx = blockIdx.x;
    const int vcu = (G % 8 == 0) ? (bx % 8) * (G / 8) + bx / 8 : bx;
    const int gw = vcu * NWAVES + wave, NGW = G * NWAVES;
    unsigned char* ws = args.ws;
    const float* x_in = args.in[0]; float* xres = args.out;
#define WFI ((bf16*)(wsl() + WS_WFI))
#define WFO ((bf16*)(wsl() + WS_WFO))
#define WFOX ((bf16*)(wsl() + WS_WFOX))
#define WGM ((bf16*)(wsl() + WS_WGM))
#define WOUT ((bf16*)(wsl() + WS_WOUT))
#define WMKV ((bf16*)(wsl() + WS_WMKV))
#define WSB ((bf16*)(wsl() + WS_WSB))
#define MEMN ((bf16*)(wsl() + WS_MEMN))
#define KVM ((bf16*)(wsl() + WS_KVM))
#define LOGF ((float*)(wsl() + WS_LOGF))
#define BIASA ((float*)(wsl() + WS_BIAS))
#define XN ((bf16*)(wsl() + WS_XN))
#define SSQ ((float*)(wsl() + WS_SSQ))
#define CAT ((bf16*)(wsl() + WS_CAT))
#define GB ((bf16*)(wsl() + WS_G))
    auto wsl = [&]() __attribute__((always_inline)) { unsigned char* p = ws; asm volatile("" : "+s"(p)); return p; };

    volatile LAS unsigned* bst = (volatile LAS unsigned*)(ldsl + 131072 + 16);
    if (tid == 0) { const unsigned x_ = xcc_id(); bst[0] = x_; __hip_atomic_fetch_add((unsigned*)wsl() + CW_XCNT(x_), 1u, __ATOMIC_RELAXED, __HIP_MEMORY_SCOPE_AGENT); }
    grid.sync();
    if (tid == 0) bst[1] = __hip_atomic_load((unsigned*)wsl() + CW_XCNT(bst[0]), __ATOMIC_RELAXED, __HIP_MEMORY_SCOPE_AGENT);
    unsigned nbar = 0;
#define GBAR() do { ++nbar; grid_bar((unsigned*)wsl(), bst, nbar, (unsigned)G); } while (0)
    {
        LAS float* scr = (LAS float*)(ldsl + wave * 16384);
        constexpr int I_FI = 16 * 176, I_FO = 44 * 32, I_FOX = 16 * 80, I_GM = 16 * 56, I_WO = 16 * 32, I_KV = 16 * 16;
        constexpr int NITEMS = 4 * I_FI + 4 * I_FO + I_FOX + I_GM + 2 * I_WO + 2 * I_KV;
        for (int it = gw; it < NITEMS; it += NGW) {
            int r = it;
            if (r < 4 * I_FI) { const int mi = r / I_FI; r -= mi * I_FI; const int layer = mi >> 1, which = mi & 1; const int kb = r / 176, nb = r % 176;
                const float* W = args.in[which ? 7 : 3] + (size_t)layer * DM * 2 * FF;
                conv_item(W, DM, 2 * FF, map_swiglu(32 * nb), WFI + (size_t)mi * 5632 * DM + (size_t)(32 * nb) * DM, 64 * kb, scr, lane, args.in[which ? 6 : 2] + layer * DM); continue; }
            r -= 4 * I_FI;
            if (r < 4 * I_FO) { const int mi = r / I_FO; r -= mi * I_FO; const int layer = mi >> 1, which = mi & 1; const int kb = r / 32, nb = r % 32;
                const float* W = args.in[which ? 8 : 4] + (size_t)layer * FF * DM;
                conv_item(W, FF, DM, map_plain(32 * nb), WFO + (size_t)mi * DM * FF + (size_t)(32 * nb) * FF, 64 * kb, scr, lane); continue; }
            r -= 4 * I_FO;
            if (r < I_FOX) { const int kb = r / 80, nb = r % 80;
                conv_item(args.in[14], DM, NFOX_SRC, map_head(32 * nb, 9, 12), WFOX + (size_t)(32 * nb) * DM, 64 * kb, scr, lane, args.in[5]); continue; }
            r -= I_FOX;
            if (r < I_GM) { const int kb = r / 56, nb = r % 56;
                conv_item(args.in[18], DM, NGM, map_head(32 * nb, 99, 0), WGM + (size_t)(32 * nb) * DM, 64 * kb, scr, lane, args.in[5] + DM); continue; }
            r -= I_GM;
            if (r < 2 * I_WO) { const int mi = r / I_WO; r -= mi * I_WO; const int kb = r / 32, nb = r % 32;
                conv_item(args.in[9] + (size_t)mi * DM * DM, DM, DM, map_plain(32 * nb), WOUT + (size_t)mi * DM * DM + (size_t)(32 * nb) * DM, 64 * kb, scr, lane); continue; }
            r -= 2 * I_WO;
            { const int mi = r / I_KV; r -= mi * I_KV; const int kb = r / 16, nb = r % 16;
                conv_item(args.in[11] + (size_t)mi * DM * 512, DM, 512, map_head(32 * nb, 99, 0), WMKV + (size_t)mi * 512 * DM + (size_t)(32 * nb) * DM, 64 * kb, scr, lane); }
        }
        for (int i = bx * (NWAVES * 64) + tid; i < 12 * 128 * 128; i += G * NWAVES * 64) { const int s = i & 127, t = (i >> 7) & 127; WSB[i] = (s <= t) ? (bf16)f2bf(args.in[20][i]) : (bf16)0; }
        { f32x4 gn[4], v[4];
#pragma unroll
          for (int j = 0; j < 4; ++j) gn[j] = ((const f32x4*)args.in[10])[lane + 64 * j];
          for (int m = gw; m < NBATCH * MEML; m += NGW) norm_row(args.in[1] + (size_t)m * DM, gn, MEMN + (size_t)m * DM, lane, v); }
        for (int m = gw; m < M; m += NGW) {
            const f32x4* xr = (const f32x4*)(args.in[0] + (size_t)m * DM) + lane; unsigned long long* o8 = (unsigned long long*)(XN + (size_t)m * DM) + lane; float ss = 0.f;
#pragma unroll
            for (int j = 0; j < 4; ++j) { const f32x4 v = xr[64 * j]; ss += (v.x * v.x + v.y * v.y) + (v.z * v.z + v.w * v.w); o8[64 * j] = (unsigned long long)pk2(v.x, v.y) | ((unsigned long long)pk2(v.z, v.w) << 32); }
            ss = wave_sum(ss); if (lane == 0) SSQ[m] = ss;
        }
        for (int i = bx * (NWAVES * 64) + tid; i < 5 * M; i += G * NWAVES * 64) SSQ[M + i] = 0.f;
        __syncthreads();
    }

    GBAR();
#pragma nounroll
    for (int half = 0; half < 4; ++half) {
        const int layer = half >> 1, which = half & 1;
        int tid = threadIdx.x; asm volatile("" : "+v"(tid)); const int lane = tid & 63;
        const float* xin = (half == 0) ? x_in : xres;
        { pg8::Gemm g{XN, WFI + (size_t)half * 5632 * DM, M, 2 * FF, DM}; pg8::StaticOrder S; S.init(M, 2 * FF, G, bx);
          pg8::EpiSwiGLU E{GB, FF, SSQ + (size_t)(layer * 3 + (which ? 2 : 0)) * M};
          pg8::gemm_phase<pg8::EpiSwiGLU, pg8::StaticOrder, true, true>(ldsl, g, S, E); }
        GBAR();
        { pg8::Gemm g{GB, WFO + (size_t)half * DM * FF, M, DM, FF}; pg8::StaticOrder S; S.init(M, DM, G, bx);
          if (half == 3) { pg8::EpiRes<false> E{xin, xres, nullptr, nullptr, 0.5f}; pg8::gemm_phase<pg8::EpiRes<false>, pg8::StaticOrder, true, true>(ldsl, g, S, E); break; }
          pg8::EpiRes<true> E{xin, xres, XN, SSQ + (size_t)(layer * 3 + (which ? 3 : 1)) * M, 0.5f};
          pg8::gemm_phase<pg8::EpiRes<true>, pg8::StaticOrder, true, true>(ldsl, g, S, E); }
        GBAR();
        if (which == 1) continue;
        const float* ssq_mix = SSQ + (size_t)(layer * 3 + 1) * M;
        if (layer == 0) {
#pragma nounroll
            for (int l2 = 0; l2 < 2; ++l2) {
                pg8::Gemm g{MEMN, WMKV + (size_t)l2 * 512 * DM, NBATCH * MEML, 512, DM}; pg8::StaticOrder S; S.init(NBATCH * MEML, 512, G, (bx + G - 8 * l2) % G);
                pg8::EpiProj<2> E{KVM + (size_t)l2 * 1024 * 512, 512, nullptr, args.in[13] + l2 * 64, nullptr, nullptr};
                pg8::gemm_phase<pg8::EpiProj<2>, pg8::StaticOrder, true, true>(ldsl, g, S, E);
                __syncthreads();
            }
            {
                LAS float* FWT = (LAS float*)ldsl;
                for (int i = tid; i < 12 * DM; i += NWAVES * 64) { const int h = i % 12, k = i / 12; FWT[h * DM + k] = args.in[14][(size_t)k * NFOX_SRC + 2304 + h] * args.in[5][k]; }
                __syncthreads();
                const float bfl = (lane < 12) ? args.in[15][lane] : 0.f;
                int gwl = gw; asm volatile("" : "+s"(gwl));
                for (int m = gwl; m < M; m += NGW) {
                    const v4u xa = *((const v4u*)(XN + (size_t)m * DM) + lane), xc = *((const v4u*)(XN + (size_t)m * DM + 512) + lane);
                    float xv[16];
#pragma unroll
                    for (int e = 0; e < 4; ++e) { xv[2 * e] = __builtin_bit_cast(float, xa[e] << 16); xv[2 * e + 1] = __builtin_bit_cast(float, xa[e] & 0xffff0000u);
                                                  xv[8 + 2 * e] = __builtin_bit_cast(float, xc[e] << 16); xv[8 + 2 * e + 1] = __builtin_bit_cast(float, xc[e] & 0xffff0000u); }
                    float fl = 0.f;
#pragma unroll
                    for (int h = 0; h < 12; ++h) {
                        const LAS f32x4* wp = (const LAS f32x4*)(FWT + h * DM + 8 * lane);
                        const f32x4 w0 = wp[0], w1 = wp[1], w2 = wp[128], w3 = wp[129];
                        float p = ((xv[0] * w0.x + xv[1] * w0.y) + (xv[2] * w0.z + xv[3] * w0.w)) + ((xv[4] * w1.x + xv[5] * w1.y) + (xv[6] * w1.z + xv[7] * w1.w))
                                + ((xv[8] * w2.x + xv[9] * w2.y) + (xv[10] * w2.z + xv[11] * w2.w)) + ((xv[12] * w3.x + xv[13] * w3.y) + (xv[14] * w3.z + xv[15] * w3.w));
                        p = wave_sum(p); if (lane == h) fl = p;
                    }
                    if (lane < 12) { const float rs = 1.0f / sqrtf(ssq_mix[m] * (1.0f / 1024.0f) + EPS); const float f = fl * rs + bfl;
                        const float lf = fminf(f, 0.f) - 0.6931471805599453f * __builtin_amdgcn_logf(1.0f + __builtin_amdgcn_exp2f(-1.4426950408889634f * fabsf(f)));
                        LOGF[(size_t)((m >> 13) * 12 + lane) * SEQ + (m & (SEQ - 1))] = lf; }
                }
                __syncthreads();
            }
            { pg8::Gemm g{XN, WFOX, M, NFOX, DM}; pg8::StaticOrder S; S.init(M, NFOX, G, bx);
              pg8::EpiProj<0> E{GB, NFOX, args.in[16], args.in[17], args.in[12], ssq_mix};
              pg8::gemm_phase<pg8::EpiProj<0>, pg8::StaticOrder, true, true>(ldsl, g, S, E); }
            GBAR();
            if (bx < 48) {
                LAS double* sw = (LAS double*)ldsl;
                const f32x4* lf4 = (const f32x4*)(LOGF + (size_t)bx * SEQ) + tid * 4;
                double loc[16]; double run = 0.0;
#pragma unroll
                for (int j = 0; j < 4; ++j) { const f32x4 q = lf4[j]; run += (double)q.x; loc[4 * j] = run; run += (double)q.y; loc[4 * j + 1] = run; run += (double)q.z; loc[4 * j + 2] = run; run += (double)q.w; loc[4 * j + 3] = run; }
                double sc = run;
#pragma unroll
                for (int o = 1; o < 64; o <<= 1) { const double y = __shfl_up(sc, o); if (lane >= o) sc += y; }
                if (lane == 63) sw[wave] = sc;
                __syncthreads();
                double woff = 0.0;
                for (int w2 = 0; w2 < wave; ++w2) woff += sw[w2];
                const double excl = sc - run + woff;
                f32x4* bo = (f32x4*)(BIASA + (size_t)bx * SEQ) + tid * 4;
#pragma unroll
                for (int j = 0; j < 4; ++j) { f32x4 o; o.x = (float)(-(excl + loc[4 * j]) * 1.4426950408889634); o.y = (float)(-(excl + loc[4 * j + 1]) * 1.4426950408889634);
                    o.z = (float)(-(excl + loc[4 * j + 2]) * 1.4426950408889634); o.w = (float)(-(excl + loc[4 * j + 3]) * 1.4426950408889634); bo[j] = o; }
                __syncthreads();
            }
        } else {
            pg8::Gemm g{XN, WGM, M, NGM, DM}; pg8::StaticOrder S; S.init(M, NGM, G, bx);
            pg8::EpiProj<1> E{GB, NGM, nullptr, args.in[19], args.in[12] + 64, ssq_mix};
            pg8::gemm_phase<pg8::EpiProj<1>, pg8::StaticOrder, true, true>(ldsl, g, S, E);
        }
        GBAR();
        if (layer == 0) {
            const attn_body::bf16* P = (const attn_body::bf16*)GB; attn_body::bf16* C = (attn_body::bf16*)CAT;
            float mq = fabsf(args.in[16][lane]), mk = fabsf(args.in[17][lane]);
#pragma unroll
            for (int o = 1; o < 64; o <<= 1) { mq = fmaxf(mq, __shfl_xor(mq, o)); mk = fmaxf(mk, __shfl_xor(mk, o)); }
            const float bound = __builtin_bit_cast(float, __builtin_amdgcn_readfirstlane(__builtin_bit_cast(int, 64.f * pg8::ATT_C2 * mq * mk * 1.02f + 0.25f)));
            const bool fixed_ok = bound <= 60.f;
            unsigned* qctr = (unsigned*)wsl();
            LAS int* qslot = (LAS int*)(ldsl + 131072);
            for (;;) {
                int tidq = threadIdx.x; asm volatile("" : "+v"(tidq)); const int laneq = tidq & 63;
                if (tidq == 0) *qslot = (int)atomicAdd(qctr, 1u);
                __syncthreads();
                const int idx = __builtin_amdgcn_readfirstlane(*qslot);
                if (idx >= 1536 + 512) break;
                if (idx >= 1536) {
                    const int u = idx - 1536, bm = u >> 5, qb = u & 31, b = bm >> 2, mh = bm & 3; const size_t rowq = (size_t)b * SEQ + qb * 256;
                    const attn_body::bf16* KV = (const attn_body::bf16*)KVM;
                    attn_body::attn_unit<8, false, false, false, 512, DM>(P + rowq * NFOX + 2304 + mh * 64, NFOX, KV + (size_t)(b * MEML) * 512 + mh * 64, KV + (size_t)(b * MEML) * 512 + 256 + mh * 64,
                                                                      C + rowq * DM + 768 + mh * 64, 4, nullptr, nullptr, 0.f, (char*)lds);
                    continue;
                }
                const int qb = 31 - idx / 48, bh = idx % 48, b = bh / 12, h = bh % 12;
                const size_t rowq = (size_t)b * SEQ + qb * 256;
                const float* bb = BIASA + (size_t)bh * SEQ;
                const int NT = 4 * qb + 4;
                if (fixed_ok) {
                    const float bq0 = bb[qb * 256];
                    const int t1 = laneq, t2 = laneq + 64;
                    const bool n1 = (t1 < NT) && (2.f * bound + bb[64 * (t1 < NT ? t1 : 0) + 63] - bq0 >= -48.f);
                    const bool n2 = (t2 < NT) && (2.f * bound + bb[64 * (t2 < NT ? t2 : 0) + 63] - bq0 >= -48.f);
                    const unsigned long long m1 = __ballot(n1), m2 = __ballot(n2);
                    int first = m1 ? (__ffsll((long long)m1) - 1) : (m2 ? 64 + (__ffsll((long long)m2) - 1) : NT);
                    int T0 = first & ~1; if (T0 > NT - 4) T0 = NT - 4;
                    T0 = __builtin_amdgcn_readfirstlane(T0);
                    const size_t rowk = (size_t)b * SEQ + (size_t)T0 * 64;
                    attn_body::attn_unit<8, true, true, true, NFOX, DM>(P + rowq * NFOX + h * 64, NFOX, P + rowk * NFOX + 768 + h * 64, P + rowk * NFOX + 1536 + h * 64,
                                                                    C + rowq * DM + h * 64, NT - T0, bb + T0 * 64, bb + qb * 256, bound, (char*)lds);
                } else {
                    const size_t rowk = (size_t)b * SEQ;
                    attn_body::attn_unit<8, true, true, false, NFOX, DM>(P + rowq * NFOX + h * 64, NFOX, P + rowk * NFOX + 768 + h * 64, P + rowk * NFOX + 1536 + h * 64,
                                                                     C + rowq * DM + h * 64, NT, bb, nullptr, 0.f, (char*)lds);
                }
            }
        } else {
            for (int u = vcu; u < 256 * 12; u += G) gmlp_unit(u / 12, u % 12, GB, WSB, args.in[21], CAT, ldsl, tid);
        }
        if (layer == 1) {
            const int QP = layer == 0 ? NFOX : NGM; const int mqc = layer == 0 ? 2304 : 1536;
            const attn_body::bf16* P = (const attn_body::bf16*)GB; attn_body::bf16* C = (attn_body::bf16*)CAT; const attn_body::bf16* KV = (const attn_body::bf16*)(KVM + (size_t)layer * 1024 * 512);
            for (int u = vcu; u < 512; u += G) {
                const int bm = u >> 5, qb = u & 31, b = bm >> 2, mh = bm & 3; const size_t rowq = (size_t)b * SEQ + qb * 256;
                attn_body::attn_unit<8, false, false, false, 512, DM>(P + rowq * QP + mqc + mh * 64, QP, KV + (size_t)(b * MEML) * 512 + mh * 64, KV + (size_t)(b * MEML) * 512 + 256 + mh * 64,
                                                           C + rowq * DM + 768 + mh * 64, 4, nullptr, nullptr, 0.f, (char*)lds);
            }
        }
        GBAR();
        { pg8::Gemm g{CAT, WOUT + (size_t)layer * DM * DM, M, DM, DM}; pg8::StaticOrder S; S.init(M, DM, G, bx);
          pg8::EpiRes<true> E{xres, xres, XN, SSQ + (size_t)(layer * 3 + 2) * M, 1.0f};
          pg8::gemm_phase<pg8::EpiRes<true>, pg8::StaticOrder, true, true>(ldsl, g, S, E); }
        GBAR();
    }
}

extern "C" void kernel_launch(void* const* d_in, const int* in_sizes, int n_in, void* d_out, int out_size, void* d_ws, size_t ws_size, hipStream_t stream) {
    static int grid_blocks = 0;
    if (grid_blocks == 0) {
        if (n_in != 22 || out_size != M * DM || ws_size < WS_END) { fprintf(stderr, "kernel_launch: unexpected problem (n_in %d, out %d, ws %zu)\n", n_in, out_size, ws_size); grid_blocks = -1; return; }
        int dev = 0, cus = 0, per_cu = 0;
        hipGetDevice(&dev);
        hipDeviceGetAttribute(&cus, hipDeviceAttributeMultiprocessorCount, dev);
        if (hipFuncSetAttribute((const void*)fwd_megakernel, hipFuncAttributeMaxDynamicSharedMemorySize, LDS_BYTES) != hipSuccess) { fprintf(stderr, "kernel_launch: hipFuncSetAttribute failed\n"); grid_blocks = -1; return; }
        if (hipOccupancyMaxActiveBlocksPerMultiprocessor(&per_cu, (const void*)fwd_megakernel, NWAVES * 64, LDS_BYTES) != hipSuccess || per_cu < 1) { fprintf(stderr, "kernel_launch: occupancy query gave %d\n", per_cu); per_cu = 1; }
        (void)hipGetLastError();
        grid_blocks = cus * per_cu;
        if (grid_blocks > 256) grid_blocks = 256;
    }
    if (grid_blocks < 0) return;
    (void)hipMemsetAsync((char*)d_ws, 0, CTL_BYTES, stream);
    Args a{};
    for (int i = 0; i < 22; ++i) a.in[i] = (const float*)d_in[i];
    a.out = (float*)d_out; a.ws = (unsigned char*)d_ws;
    void* kargs[] = {&a};
    hipError_t e = hipLaunchCooperativeKernel((const void*)fwd_megakernel, dim3(grid_blocks), dim3(NWAVES * 64), kargs, LDS_BYTES, stream);
    if (e != hipSuccess) fprintf(stderr, "cooperative launch failed: %s (grid %d)\n", hipGetErrorString(e), grid_blocks);
}
```

```cpp
#include <hip/hip_runtime.h>
#include <hip/hip_cooperative_groups.h>
#include <hip/hip_bf16.h>
#include <cstdio>
#include <cstdint>
#include <cmath>
namespace cg = cooperative_groups;
namespace pg8 {
#define PG8_LAS __attribute__((address_space(3)))
typedef unsigned short bf16_t;
typedef short bf16x8 __attribute__((ext_vector_type(8)));
typedef float f32x4 __attribute__((ext_vector_type(4)));
typedef unsigned u32x4 __attribute__((ext_vector_type(4)));
constexpr int BM = 256, BK = 64, HALF = 128, HTB = HALF * BK * 2  , STAGE_BYTES = 8 * HTB, NXCD = 8, WGM = 8;

__host__ __device__ __forceinline__ int lds_byte(int r, int c) { const int st = (r >> 4) * 2 + (c >> 5), rr = r & 15, cc = c & 31, ob = rr * 64 + cc * 2; return st * 1024 + (ob ^ (((ob >> 9) & 1) << 5)); }
__host__ __device__ __forceinline__ void stage_rc(int b, int& R, int& C) { const int st = b / 1024, sb = b % 1024, swz = sb ^ (((sb >> 9) & 1) << 5); R = (st >> 1) * 16 + swz / 64; C = (st & 1) * 32 + (swz % 64) / 2; }
__host__ __device__ __forceinline__ int perm32(int rho) { const int n = rho >> 4, i = rho & 15; return 8 * (i >> 2) + 4 * n + (i & 3); }

struct Unit { int pm, pn; };
struct Gemm { const bf16_t* A; const bf16_t* Bt; int M, N, K; };

struct StaticOrder {
    int nM, nN, nwg, G, c;
    __host__ __device__ void init(int M, int N, int G_, int c_) { nM = M / BM; nN = N / BM; nwg = nM * nN; G = G_; c = c_; }
    __host__ __device__ bool next(int i, Unit& u) const {
        const long L = (long)i * G + c; if (L >= nwg) return false;
        int wgid = (int)L; { const int q = nwg / NXCD, r = nwg % NXCD, xcd = wgid % NXCD, off = wgid / NXCD; wgid = (xcd < r ? xcd * (q + 1) : r * (q + 1) + (xcd - r) * q) + off; }
        const int nig = WGM * nN, gid = wgid / nig, fm = gid * WGM, gsz = (nM - fm) < WGM ? (nM - fm) : WGM;
        u.pm = fm + ((wgid % nig) % gsz); u.pn = (wgid % nig) / gsz; return true;
    }
    __device__ __forceinline__ void a_ready(const Unit&) const {}
    __device__ __forceinline__ void done(const Unit&) const {}
};
__device__ __forceinline__ unsigned cvt_pk_bf16(float lo, float hi) { unsigned r; asm volatile("v_cvt_pk_bf16_f32 %0, %1, %2" : "=v"(r) : "v"(lo), "v"(hi)); return r; }
typedef float f32x2 __attribute__((ext_vector_type(2)));
typedef unsigned u32x2 __attribute__((ext_vector_type(2)));
__device__ __forceinline__ float mul_sigmoid(float v, float z) { return v * __builtin_amdgcn_rcpf(1.0f + __builtin_amdgcn_exp2f(-1.4426950408889634f * z)); }
__device__ __forceinline__ float gelu_tanh(float v) { return mul_sigmoid(v, 1.5957691216057308f * (v + 0.044715f * v * v * v)); }
constexpr float ATT_C2 = 0.125f * 1.4426950408889634f;

struct EpiSwiGLU {
    static constexpr bool PERM = true, AFTER_DRAIN = false;
    bf16_t* O; int ldc; const float* ssq;
    __device__ __forceinline__ void operator()(const f32x4 (&acc)[2][2][4][2], const Unit& u, int wr, int wc, int fr, int fq) const {
        const int row0 = u.pm * BM + wr * 64 + fr; const int col0 = u.pn * 128 + wc * 32 + 8 * fq;
#pragma unroll
        for (int ai = 0; ai < 2; ++ai)
#pragma unroll
            for (int m = 0; m < 4; ++m) {
                bf16_t* p = O + (size_t)(row0 + ai * HALF + m * 16) * ldc + col0;
                const float rs = __builtin_amdgcn_rsqf(ssq[row0 + ai * HALF + m * 16] * (1.0f / 1024.0f) + 1e-6f);
                const f32x4 a0 = acc[ai][0][m][0] * rs, a1 = acc[ai][0][m][1] * rs, b0 = acc[ai][1][m][0] * rs, b1 = acc[ai][1][m][1] * rs;
                u32x4 w;
                w.x = cvt_pk_bf16(mul_sigmoid(a0[0], a0[0]) * b0[0], mul_sigmoid(a0[1], a0[1]) * b0[1]);
                w.y = cvt_pk_bf16(mul_sigmoid(a0[2], a0[2]) * b0[2], mul_sigmoid(a0[3], a0[3]) * b0[3]);
                w.z = cvt_pk_bf16(mul_sigmoid(a1[0], a1[0]) * b1[0], mul_sigmoid(a1[1], a1[1]) * b1[1]);
                w.w = cvt_pk_bf16(mul_sigmoid(a1[2], a1[2]) * b1[2], mul_sigmoid(a1[3], a1[3]) * b1[3]);
                *(u32x4*)p = w;
            }
    }
};
template <bool WXB> struct EpiRes {
    static constexpr bool PERM = true, AFTER_DRAIN = false;
    const float* xin; float* xout; bf16_t* xb; float* ssq; float s;
    __device__ __forceinline__ void operator()(const f32x4 (&acc)[2][2][4][2], const Unit& u, int wr, int wc, int fr, int fq) const {
        const int row0 = u.pm * BM + wr * 64 + fr; const int col0 = u.pn * BM + wc * 32 + 8 * fq;
#pragma unroll
        for (int ai = 0; ai < 2; ++ai)
#pragma unroll
            for (int m = 0; m < 4; ++m) {
                const int row = row0 + ai * HALF + m * 16; const size_t off = (size_t)row * 1024 + col0; float ss = 0.f;
#pragma unroll
                for (int bj = 0; bj < 2; ++bj) {
                    const f32x4 o0 = *(const f32x4*)(xin + off + bj * HALF) + acc[ai][bj][m][0] * s, o1 = *(const f32x4*)(xin + off + bj * HALF + 4) + acc[ai][bj][m][1] * s;
                    *(f32x4*)(xout + off + bj * HALF) = o0; *(f32x4*)(xout + off + bj * HALF + 4) = o1;
                    if (WXB) { u32x4 w; w.x = cvt_pk_bf16(o0[0], o0[1]); w.y = cvt_pk_bf16(o0[2], o0[3]); w.z = cvt_pk_bf16(o1[0], o1[1]); w.w = cvt_pk_bf16(o1[2], o1[3]); *(u32x4*)(xb + off + bj * HALF) = w;
                        ss += ((o0[0] * o0[0] + o0[1] * o0[1]) + (o0[2] * o0[2] + o0[3] * o0[3])) + ((o1[0] * o1[0] + o1[1] * o1[1]) + (o1[2] * o1[2] + o1[3] * o1[3])); }
                }
                if (WXB) { ss += __shfl_xor(ss, 16); ss += __shfl_xor(ss, 32); if (fq == 0) unsafeAtomicAdd(ssq + row, ss); }
            }
    }
};
template <int KIND> struct EpiProj {
    static constexpr bool PERM = true, AFTER_DRAIN = false;
    bf16_t* O; int ldc; const float* gq; const float* gk; const float* gm; const float* ssq;
    __device__ __forceinline__ void operator()(const f32x4 (&acc)[2][2][4][2], const Unit& u, int wr, int wc, int fr, int fq) const {
        int mode = 0; const float* g = gk; float sc = 1.f; const int pn = u.pn;
        if (KIND == 0) { if (pn < 3) { mode = 1; g = gq; sc = ATT_C2; } else if (pn < 6) { mode = 1; g = gk; } else if (pn < 9) { mode = 0; } else { mode = 1; g = gm; sc = ATT_C2; } }
        else if (KIND == 1) { if (pn < 3) { mode = 2; } else if (pn < 6) { mode = 3; g = gk + (4 * (pn - 3) + wc) * 64; } else { mode = 1; g = gm; sc = ATT_C2; } }
        else { if (pn == 0) { mode = 1; g = gk; } else { mode = 0; } }
        f32x4 gv[2][2];
#pragma unroll
        for (int bj = 0; bj < 2; ++bj)
#pragma unroll
            for (int n = 0; n < 2; ++n) gv[bj][n] = (mode & 1) ? *(const f32x4*)(g + 32 * bj + 8 * fq + 4 * n) * sc : (f32x4){1.f, 1.f, 1.f, 1.f};
        const int row0 = u.pm * BM + wr * 64 + fr; const int col0 = pn * BM + wc * 64 + 8 * fq;
#pragma unroll
        for (int ai = 0; ai < 2; ++ai)
#pragma unroll
            for (int m = 0; m < 4; ++m) {
                f32x4 v[2][2];
#pragma unroll
                for (int bj = 0; bj < 2; ++bj)
#pragma unroll
                    for (int n = 0; n < 2; ++n) v[bj][n] = acc[ai][bj][m][n];
                if (KIND != 2) { const float rs = __builtin_amdgcn_rsqf(ssq[row0 + ai * HALF + m * 16] * (1.0f / 1024.0f) + 1e-6f);
#pragma unroll
                    for (int bj = 0; bj < 2; ++bj)
#pragma unroll
                        for (int n = 0; n < 2; ++n) v[bj][n] = v[bj][n] * rs; }
                if (mode & 2) {
#pragma unroll
                    for (int bj = 0; bj < 2; ++bj)
#pragma unroll
                        for (int n = 0; n < 2; ++n)
#pragma unroll
                            for (int e = 0; e < 4; ++e) v[bj][n][e] = gelu_tanh(v[bj][n][e]);
                }
                if (mode & 1) {
                    float ss = 0.f;
#pragma unroll
                    for (int bj = 0; bj < 2; ++bj)
#pragma unroll
                        for (int n = 0; n < 2; ++n) { const f32x4 x = v[bj][n]; ss += (x[0] * x[0] + x[1] * x[1]) + (x[2] * x[2] + x[3] * x[3]); }
                    ss += __shfl_xor(ss, 16); ss += __shfl_xor(ss, 32);
                    const float r = __builtin_amdgcn_rsqf(ss * (1.0f / 64.0f) + 1e-6f);
#pragma unroll
                    for (int bj = 0; bj < 2; ++bj)
#pragma unroll
                        for (int n = 0; n < 2; ++n) v[bj][n] = v[bj][n] * r * gv[bj][n];
                }
                bf16_t* p = O + (size_t)(row0 + ai * HALF + m * 16) * ldc + col0;
#pragma unroll
                for (int bj = 0; bj < 2; ++bj) {
                    u32x4 w; w.x = cvt_pk_bf16(v[bj][0][0], v[bj][0][1]); w.y = cvt_pk_bf16(v[bj][0][2], v[bj][0][3]); w.z = cvt_pk_bf16(v[bj][1][0], v[bj][1][1]); w.w = cvt_pk_bf16(v[bj][1][2], v[bj][1][3]);
                    *(u32x4*)(p + 32 * bj) = w;
                }
            }
    }
};
template <class Epi, class Sched, bool ALIGN_EPI = false, bool SP2 = false>
__device__ __forceinline__ void gemm_phase(PG8_LAS unsigned char* lds, const Gemm g, const Sched& S, const Epi& E) {
    int tid_l = threadIdx.x; asm volatile("" : "+v"(tid_l));
    const int tid = tid_l, wid = __builtin_amdgcn_readfirstlane(tid >> 6), lane = tid & 63, wr = wid >> 2, wc = wid & 3, fr = lane & 15, fq = lane >> 4;
    const int K = g.K, nt = K / BK;
    unsigned voffA[2], voffB[2];
#pragma unroll
    for (int i = 0; i < 2; ++i) { int R, C; stage_rc(tid * 16 + i * 8192, R, C); const int Rb = Epi::PERM ? ((R & ~31) + perm32(R & 31)) : R;
        voffA[i] = (unsigned)(R * K + C) * 2u; voffB[i] = (unsigned)(Rb * K + C) * 2u; }
    const size_t kstep = (size_t)(BK * 2);
    const size_t hstep = (size_t)HALF * K * 2;
    const size_t tstep = 2 * hstep;
    const unsigned ldsw = (unsigned)wid * 1024u;
    const int aoff = lds_byte(wr * 64 + fr, fq * 8), boff = lds_byte(wc * 32 + fr, fq * 8);
#define PG8_SA(b, h) (((b) * 2 + (h)) * HTB)
#define PG8_SB(b, h) ((4 + (b) * 2 + (h)) * HTB)
#define PG8_STAGE(bufoff, gbase, voff) do { _Pragma("unroll") for (int _i = 0; _i < 2; ++_i) \
        __builtin_amdgcn_global_load_lds((const unsigned*)((const char*)(gbase) + (voff)[_i]), (PG8_LAS unsigned*)(lds + (bufoff) + ldsw + _i * 8192), 16, 0, 0); } while (0)
#define PG8_LDA(dst, b, h) do { _Pragma("unroll") for (int m = 0; m < 4; ++m) _Pragma("unroll") for (int k = 0; k < 2; ++k) dst[m][k] = *(const PG8_LAS bf16x8*)(lds + PG8_SA(b, h) + aoff + m * 2048 + k * 1024); } while (0)
#define PG8_LDB(dst, b, h) do { _Pragma("unroll") for (int n = 0; n < 2; ++n) _Pragma("unroll") for (int k = 0; k < 2; ++k) dst[n][k] = *(const PG8_LAS bf16x8*)(lds + PG8_SB(b, h) + boff + n * 2048 + k * 1024); } while (0)
#define PG8_MMA(ai, bj, At, Bt) do { __builtin_amdgcn_s_setprio(1); _Pragma("unroll") for (int m = 0; m < 4; ++m) _Pragma("unroll") for (int n = 0; n < 2; ++n) _Pragma("unroll") for (int k = 0; k < 2; ++k) \
        acc[ai][bj][m][n] = __builtin_amdgcn_mfma_f32_16x16x32_bf16(Bt[n][k], At[m][k], acc[ai][bj][m][n], 0, 0, 0); __builtin_amdgcn_s_setprio(0); } while (0)
#define PG8_WAIT_V(n) asm volatile("s_waitcnt vmcnt(" #n ")" ::: "memory")
#define PG8_WAIT_L(n) asm volatile("s_waitcnt lgkmcnt(" #n ")" ::: "memory")
#define PG8_BAR __builtin_amdgcn_s_barrier()
#define PG8_SCHED __builtin_amdgcn_sched_barrier(0)
    Unit cur, nxt; int ui = 0;
    if (!S.next(0, cur)) return;
    f32x4 acc[2][2][4][2];
#pragma unroll
    for (int a = 0; a < 2; ++a)
#pragma unroll
        for (int b = 0; b < 2; ++b)
#pragma unroll
            for (int m = 0; m < 4; ++m)
#pragma unroll
                for (int n = 0; n < 2; ++n) acc[a][b][m][n] = (f32x4){0.f, 0.f, 0.f, 0.f};
    bf16x8 At[4][2], B0[2][2], B1[2][2];
    const char* cA = (const char*)g.A + (size_t)cur.pm * tstep; const char* cB = (const char*)g.Bt + (size_t)cur.pn * tstep;
    S.a_ready(cur);
    if constexpr (SP2) {
        PG8_STAGE(PG8_SB(0, 0), cB, voffB); PG8_STAGE(PG8_SB(0, 1), cB + hstep, voffB); PG8_STAGE(PG8_SA(0, 0), cA, voffA); PG8_STAGE(PG8_SA(0, 1), cA + hstep, voffA);
        if (wr == 1) PG8_BAR;
        PG8_WAIT_V(2); PG8_BAR;
        PG8_STAGE(PG8_SB(1, 0), cB + kstep, voffB); PG8_STAGE(PG8_SA(1, 0), cA + kstep, voffA); PG8_STAGE(PG8_SB(1, 1), cB + hstep + kstep, voffB);
        PG8_WAIT_V(6); PG8_BAR;
    } else {
        PG8_STAGE(PG8_SB(0, 0), cB, voffB); PG8_STAGE(PG8_SA(0, 0), cA, voffA); PG8_STAGE(PG8_SB(0, 1), cB + hstep, voffB); PG8_STAGE(PG8_SA(0, 1), cA + hstep, voffA);
        if (wr == 1) PG8_BAR;
        PG8_WAIT_V(4); PG8_BAR;
        PG8_STAGE(PG8_SB(1, 0), cB + kstep, voffB); PG8_STAGE(PG8_SA(1, 0), cA + kstep, voffA); PG8_STAGE(PG8_SB(1, 1), cB + hstep + kstep, voffB);
        PG8_WAIT_V(6); PG8_BAR;
    }
    for (;;) {
        const bool has_next = S.next(ui + 1, nxt);
        const char* nA = has_next ? (const char*)g.A + (size_t)nxt.pm * tstep : cA; const char* nB = has_next ? (const char*)g.Bt + (size_t)nxt.pn * tstep : cB;
        for (int t = 0; t < nt; t += 2) {
            const bool last = (t == nt - 2);
            const char* a1 = cA + (size_t)(t + 1) * kstep;
            const char* a2 = last ? nA : cA + (size_t)(t + 2) * kstep; const char* b2 = last ? nB : cB + (size_t)(t + 2) * kstep;
            const char* a3 = a2 + kstep; const char* b3 = b2 + kstep;
            if (last && has_next) S.a_ready(nxt);
            if constexpr (SP2) {
            PG8_LDB(B0, 0, 0); PG8_LDB(B1, 0, 1); PG8_SCHED; PG8_LDA(At, 0, 0); PG8_STAGE(PG8_SA(1, 1), a1 + hstep, voffA);
            PG8_WAIT_V(8); PG8_WAIT_L(0); PG8_BAR; PG8_MMA(0, 0, At, B0); PG8_MMA(0, 1, At, B1); PG8_BAR; PG8_SCHED;
            PG8_LDA(At, 0, 1); PG8_STAGE(PG8_SB(0, 0), b2, voffB); PG8_STAGE(PG8_SB(0, 1), b2 + hstep, voffB); PG8_STAGE(PG8_SA(0, 0), a2, voffA);
            PG8_WAIT_V(8); PG8_WAIT_L(0); PG8_BAR; PG8_MMA(1, 0, At, B0); PG8_MMA(1, 1, At, B1); PG8_BAR; PG8_SCHED;
            PG8_LDB(B0, 1, 0); PG8_LDB(B1, 1, 1); PG8_SCHED; PG8_LDA(At, 1, 0); PG8_STAGE(PG8_SA(0, 1), a2 + hstep, voffA);
            PG8_WAIT_V(8); PG8_WAIT_L(0); PG8_BAR; PG8_MMA(0, 0, At, B0); PG8_MMA(0, 1, At, B1); PG8_BAR; PG8_SCHED;
            PG8_LDA(At, 1, 1); PG8_STAGE(PG8_SB(1, 0), b3, voffB); PG8_STAGE(PG8_SB(1, 1), b3 + hstep, voffB); PG8_STAGE(PG8_SA(1, 0), a3, voffA);
            PG8_WAIT_V(8); PG8_WAIT_L(0); PG8_BAR; PG8_MMA(1, 0, At, B0); PG8_MMA(1, 1, At, B1); PG8_BAR; PG8_SCHED;
            } else {
            PG8_LDB(B0, 0, 0); PG8_SCHED; PG8_LDA(At, 0, 0); PG8_STAGE(PG8_SA(1, 1), a1 + hstep, voffA);
            PG8_WAIT_L(8); PG8_BAR; PG8_WAIT_L(0); PG8_MMA(0, 0, At, B0); PG8_BAR; PG8_SCHED;
            PG8_LDB(B1, 0, 1); PG8_STAGE(PG8_SB(0, 0), b2, voffB);
            PG8_BAR; PG8_WAIT_L(0); PG8_MMA(0, 1, At, B1); PG8_BAR;
            PG8_LDA(At, 0, 1); PG8_STAGE(PG8_SA(0, 0), a2, voffA);
            PG8_BAR; PG8_WAIT_L(0); PG8_MMA(1, 0, At, B0); PG8_BAR; PG8_SCHED;
            PG8_STAGE(PG8_SB(0, 1), b2 + hstep, voffB);
            PG8_WAIT_V(6); PG8_BAR; PG8_MMA(1, 1, At, B1); PG8_BAR;
            PG8_LDB(B0, 1, 0); PG8_SCHED; PG8_LDA(At, 1, 0); PG8_STAGE(PG8_SA(0, 1), a2 + hstep, voffA);
            PG8_WAIT_L(8); PG8_BAR; PG8_WAIT_L(0); PG8_MMA(0, 0, At, B0); PG8_BAR; PG8_SCHED;
            PG8_LDB(B1, 1, 1); PG8_STAGE(PG8_SB(1, 0), b3, voffB);
            PG8_BAR; PG8_WAIT_L(0); PG8_MMA(0, 1, At, B1); PG8_BAR;
            PG8_LDA(At, 1, 1); PG8_STAGE(PG8_SA(1, 0), a3, voffA);
            PG8_BAR; PG8_WAIT_L(0); PG8_MMA(1, 0, At, B0); PG8_BAR; PG8_SCHED;
            PG8_STAGE(PG8_SB(1, 1), b3 + hstep, voffB);
            PG8_WAIT_V(6); PG8_BAR; PG8_MMA(1, 1, At, B1); PG8_BAR;
            }
        }
        if constexpr (ALIGN_EPI) { if (wr == 0) PG8_BAR; }
        if constexpr (!Epi::AFTER_DRAIN) { E(acc, cur, wr, wc, fr, fq); S.done(cur); }
        if (!has_next) break;
#pragma unroll
        for (int a = 0; a < 2; ++a)
#pragma unroll
            for (int b = 0; b < 2; ++b)
#pragma unroll
                for (int m = 0; m < 4; ++m)
#pragma unroll
                    for (int n = 0; n < 2; ++n) acc[a][b][m][n] = (f32x4){0.f, 0.f, 0.f, 0.f};
        cur = nxt; cA = nA; cB = nB; ++ui;
        if constexpr (ALIGN_EPI) { if (wr == 1) PG8_BAR; }
    }
    PG8_WAIT_V(0);
    if constexpr (!ALIGN_EPI) { if (wr == 0) PG8_BAR; }
    PG8_BAR;
    if constexpr (Epi::AFTER_DRAIN) { E.fused(acc, cur, wr, wc, fr, fq, lds, wid, lane); S.done(cur); }
#undef PG8_SA
#undef PG8_SB
#undef PG8_STAGE
#undef PG8_LDA
#undef PG8_LDB
#undef PG8_MMA
#undef PG8_WAIT_V
#undef PG8_WAIT_L
#undef PG8_BAR
#undef PG8_SCHED
}
}
#include <hip/hip_bf16.h>
#include <cmath>
namespace attn_body {
using bf16=__hip_bfloat16;
using bf16x8=__attribute__((ext_vector_type(8)))short;
using s16x4=__attribute__((ext_vector_type(4)))short;
using f32x16=__attribute__((ext_vector_type(16)))float;
using u32x4=__attribute__((ext_vector_type(4)))unsigned;
using f32x4v=__attribute__((ext_vector_type(4)))float;
constexpr int D=64;
constexpr int NW=8,QBLK=32,QB=QBLK*NW,KVBLK=64;
__device__ __forceinline__ int crow(int r,int hi){return (r&3)+8*(r>>2)+4*hi;}
#define SBAR() __builtin_amdgcn_sched_barrier(0)
__device__ __forceinline__ void cmask(f32x16&p0,f32x16&p1,int jb,int qrel,int hi){
  const float NEG=-INFINITY; int kb=64*jb+4*hi;
  #pragma unroll
  for(int r=0;r<16;++r){int kv=kb+(r&3)+8*(r>>2); if(kv>qrel)p0[r]=NEG; if(kv+32>qrel)p1[r]=NEG;}
}

constexpr int NSLOT=3, SLOTB=8192;
constexpr int LDS_K=0, LDS_V=NSLOT*SLOTB, LDS_WS=2*NSLOT*SLOTB, LDS_OST=LDS_WS+NW*64*4, LDS_BIAS=LDS_OST+NW*4096, LDS_BYTES=LDS_BIAS+32768;
constexpr float C2=0.125f*1.4426950408889634f;
__device__ __forceinline__ void glds16(const void*gsrc,unsigned lds_dst){unsigned keep;
  asm volatile("s_mov_b32 %0, m0\n\ts_mov_b32 m0, %2\n\ts_nop 0\n\tglobal_load_lds_dwordx4 %1, off\n\ts_mov_b32 m0, %0":"=&s"(keep):"v"(gsrc),"s"(lds_dst):"memory");}
__device__ __forceinline__ float max3f(float a,float b,float c){float r;asm("v_max3_f32 %0, %1, %2, %3":"=v"(r):"v"(a),"v"(b),"v"(c));return r;}
__device__ __forceinline__ float max2f(float a,float b){float r;asm("v_max_f32_e32 %0, %1, %2":"=v"(r):"v"(a),"v"(b));return r;}
__device__ __forceinline__ float fadd_s(float a,float b){float r;asm("v_add_f32_e32 %0, %1, %2":"=v"(r):"v"(a),"v"(b));return r;}
__device__ __forceinline__ float fsub_s(float a,float b){float r;asm("v_sub_f32_e32 %0, %1, %2":"=v"(r):"v"(a),"v"(b));return r;}
typedef float f32x2_t __attribute__((ext_vector_type(2))); typedef __bf16 bf16x2_t __attribute__((ext_vector_type(2)));
__device__ __forceinline__ unsigned cvtpk_s(float lo,float hi){f32x2_t v={lo,hi};bf16x2_t b=__builtin_convertvector(v,bf16x2_t);return __builtin_bit_cast(unsigned,b);}
#define WAIT_BAR(N) asm volatile("s_waitcnt vmcnt(" #N ") lgkmcnt(0)\n\ts_barrier":::"memory")

__device__ __forceinline__ void qkt(f32x16&p0,f32x16&p1,const char*Kslot,const bf16x8*qr,const f32x16&negm,int r32,int hi){
  const char*kb=Kslot+hi*1024+r32*16;
  #pragma unroll
  for(int d0=0;d0<4;++d0){
    const bf16x8 b0=*reinterpret_cast<const bf16x8*>(kb+d0*2048);
    const bf16x8 b1=*reinterpret_cast<const bf16x8*>(kb+d0*2048+512);
    if(d0==0){p0=__builtin_amdgcn_mfma_f32_32x32x16_bf16(b0,qr[0],negm,0,0,0);p1=__builtin_amdgcn_mfma_f32_32x32x16_bf16(b1,qr[0],negm,0,0,0);}
    else{p0=__builtin_amdgcn_mfma_f32_32x32x16_bf16(b0,qr[d0],p0,0,0,0);p1=__builtin_amdgcn_mfma_f32_32x32x16_bf16(b1,qr[d0],p1,0,0,0);}}
}
typedef __attribute__((address_space(3))) const char* lds_cptr;
typedef short v4i16_t __attribute__((ext_vector_type(4)));
__device__ __forceinline__ void kload8(bf16x8*kf,lds_cptr kp){
  kf[0]=*(const __attribute__((address_space(3))) bf16x8*)(kp);      kf[1]=*(const __attribute__((address_space(3))) bf16x8*)(kp+512);
  kf[2]=*(const __attribute__((address_space(3))) bf16x8*)(kp+2048); kf[3]=*(const __attribute__((address_space(3))) bf16x8*)(kp+2560);
  kf[4]=*(const __attribute__((address_space(3))) bf16x8*)(kp+4096); kf[5]=*(const __attribute__((address_space(3))) bf16x8*)(kp+4608);
  kf[6]=*(const __attribute__((address_space(3))) bf16x8*)(kp+6144); kf[7]=*(const __attribute__((address_space(3))) bf16x8*)(kp+6656);
}
__device__ __forceinline__ void kload2(bf16x8*kf,lds_cptr kp,int j){ kf[2*j]=*(const __attribute__((address_space(3))) bf16x8*)(kp+j*2048); kf[2*j+1]=*(const __attribute__((address_space(3))) bf16x8*)(kp+j*2048+512); }
__device__ __forceinline__ s16x4 vtr(lds_cptr p){ return __builtin_bit_cast(s16x4,__builtin_amdgcn_ds_read_tr16_b64_v4i16((__attribute__((address_space(3))) v4i16_t*)p)); }
__device__ __forceinline__ float rowmax(const f32x16&p0,const f32x16&p1){
  float a=max3f(p0[0],p0[1],p1[0]),b=max3f(p0[2],p0[3],p1[1]);a=max3f(a,p1[2],p1[3]);
  #pragma unroll
  for(int r=4;r<16;r+=4){a=max3f(a,p0[r],p0[r+1]);b=max3f(b,p0[r+2],p0[r+3]);a=max3f(a,p1[r],p1[r+1]);b=max3f(b,p1[r+2],p1[r+3]);}
  const float m=max2f(a,b);
  auto rr=__builtin_amdgcn_permlane32_swap(__float_as_uint(m),__float_as_uint(m),false,false);
  return max2f(__uint_as_float(rr[0]),__uint_as_float(rr[1]));
}
__device__ __forceinline__ void pv(f32x16*o,int vb,bf16x8 pa0,bf16x8 pa1,bf16x8 pa2,bf16x8 pa3){
  #pragma unroll
  for(int d0=0;d0<2;++d0){s16x4 lo[4],hi[4];
    #pragma unroll
    for(int ks=0;ks<4;++ks){
      asm volatile("ds_read_b64_tr_b16 %0,%1 offset:%c2":"=&v"(lo[ks]):"v"(vb),"i"(d0*4096+ks*1024):"memory");
      asm volatile("ds_read_b64_tr_b16 %0,%1 offset:%c2":"=&v"(hi[ks]):"v"(vb),"i"(d0*4096+ks*1024+512):"memory");}
    asm volatile("s_waitcnt lgkmcnt(0)":::"memory");SBAR();
    #define PK(k) (bf16x8){lo[k][0],lo[k][1],lo[k][2],lo[k][3],hi[k][0],hi[k][1],hi[k][2],hi[k][3]}
    o[d0]=__builtin_amdgcn_mfma_f32_32x32x16_bf16(pa0,PK(0),o[d0],0,0,0);
    o[d0]=__builtin_amdgcn_mfma_f32_32x32x16_bf16(pa1,PK(1),o[d0],0,0,0);
    o[d0]=__builtin_amdgcn_mfma_f32_32x32x16_bf16(pa2,PK(2),o[d0],0,0,0);
    o[d0]=__builtin_amdgcn_mfma_f32_32x32x16_bf16(pa3,PK(3),o[d0],0,0,0);
    #undef PK
  }
}

#ifndef ATTN_STORE16
#define ATTN_STORE16(p,v) (*(u32x4*)(p)=(v))
#endif
template<int THRL,bool CAUSAL,bool BIAS,bool FIXED,int KP,int OP> __device__ __forceinline__ void attn_unit(const bf16*Qb,const int QP,const bf16*__restrict__ Kh,const bf16*__restrict__ Vh,bf16*Ob,const int NT_,const float*__restrict__ biasg,const float*__restrict__ biasq,const float bound,char*shm){
  int tid_l=threadIdx.x; asm volatile("":"+v"(tid_l)); const int tid=tid_l,lane=tid&63,r32=lane&31,hi=lane>>5; const int wid=__builtin_amdgcn_readfirstlane(tid>>6);
  const bf16*Qw=Qb+(long)(wid*QBLK)*QP;
  const lds_cptr shm3=(lds_cptr)shm;
  const unsigned lds0=(unsigned)(uintptr_t)shm;
  float*wsf=(float*)(shm+LDS_WS)+wid*64;
  const bf16*ksrc=Kh+(long)lane*KP+wid*8;
  const bf16*vsrc=Vh+(long)(16*(wid&3)+(lane>>2))*KP+(wid>>2)*32+(lane&3)*8;
  const unsigned kdst=lds0+LDS_K+wid*1024, vdst=lds0+LDS_V+wid*1024;
  #define DMA_K(t,slot) glds16(ksrc+(long)(t)*KVBLK*KP,(unsigned)__builtin_amdgcn_readfirstlane(kdst+(slot)))
  #define DMA_V(t,slot) glds16(vsrc+(long)(t)*KVBLK*KP,(unsigned)__builtin_amdgcn_readfirstlane(vdst+(slot)))
  const int vb0=(int)(lds0+LDS_V)+((lane>>4)&1)*32+(lane&3)*8+(4*hi+((lane&15)>>2))*64;
  const char*Kbase=shm+LDS_K; bf16x8 kf[8];
  const lds_cptr kp0=shm3+LDS_K+hi*1024+r32*16; const lds_cptr vp0=shm3+LDS_V+((lane>>4)&1)*32+(lane&3)*8+(4*hi+((lane&15)>>2))*64;
  const int NT=NT_;
  typedef __attribute__((address_space(3))) f32x4v* lds_f4p;
  if(BIAS){ const lds_f4p bl=(lds_f4p)(shm3+LDS_BIAS); const int n4=NT*16; for(int i=tid;i<n4;i+=NW*64){ bl[i]=((const f32x4v*)biasg)[i]; } }
  #define BIASADD(P0,P1,t) do{ if(BIAS){ const __attribute__((address_space(3))) f32x4v* bp_=(const __attribute__((address_space(3))) f32x4v*)(shm3+LDS_BIAS+(hi<<4))+(t)*16; \
    const float sub_=FIXED?refq:mhat; const f32x2_t s2_={sub_,sub_}; \
    _Pragma("unroll") for(int j_=0;j_<4;++j_){ const f32x4v b0_=bp_[2*j_], b1_=bp_[8+2*j_]; \
      const f32x2_t a0_=(f32x2_t){b0_[0],b0_[1]}-s2_, a1_=(f32x2_t){b0_[2],b0_[3]}-s2_, c0_=(f32x2_t){b1_[0],b1_[1]}-s2_, c1_=(f32x2_t){b1_[2],b1_[3]}-s2_; \
      const f32x2_t p0_=(f32x2_t){P0[4*j_],P0[4*j_+1]}+a0_, p1_=(f32x2_t){P0[4*j_+2],P0[4*j_+3]}+a1_, q0_=(f32x2_t){P1[4*j_],P1[4*j_+1]}+c0_, q1_=(f32x2_t){P1[4*j_+2],P1[4*j_+3]}+c1_; \
      P0[4*j_]=p0_[0];P0[4*j_+1]=p0_[1];P0[4*j_+2]=p1_[0];P0[4*j_+3]=p1_[1]; P1[4*j_]=q0_[0];P1[4*j_+1]=q0_[1];P1[4*j_+2]=q1_[0];P1[4*j_+3]=q1_[1]; } } }while(0)
  DMA_K(0,0);DMA_V(0,0);DMA_K(1,SLOTB);
  bf16x8 qr[4];
  #pragma unroll
  for(int d0=0;d0<4;++d0)qr[d0]=*reinterpret_cast<const bf16x8*>(&Qw[(long)r32*QP+d0*16+hi*8]);
  float mhat=0.f,l_reg=0.f;f32x16 o[2];f32x16 negm; { float z0_; asm volatile("v_mov_b32 %0, 0":"=v"(z0_)); _Pragma("unroll") for(int r=0;r<16;++r){o[0][r]=z0_;o[1][r]=z0_;negm[r]=z0_;} } float refq=0.f; if(FIXED){ refq=biasq[wid*QBLK+r32]+bound; } if(!BIAS)asm volatile("":"+v"(negm));
  const int qrel=wid*QBLK+r32;
  #define CMASK(P0,P1,t) do{ if(CAUSAL){int jb_=(t)-(NT-4); if(jb_>=0)cmask(P0,P1,jb_,qrel,hi);} }while(0)
  bool resc=false;
  #define START(P0,P1) do{ resc=false; \
    if(!FIXED){ const float rm=rowmax(P0,P1); const float dl=rm; mhat=fadd_s(mhat,dl); \
      _Pragma("unroll") for(int r=0;r<16;++r){P0[r]=fsub_s(P0[r],dl);P1[r]=fsub_s(P1[r],dl);} \
      if(!BIAS){ _Pragma("unroll") for(int r=0;r<16;++r)negm[r]=-mhat; asm volatile("":"+v"(negm)); } } \
    _Pragma("unroll") for(int r=0;r<16;++r)P0[r]=__builtin_amdgcn_exp2f(P0[r]); }while(0)
  #define RESC() do{ if(!FIXED&&resc){ asm volatile("s_waitcnt lgkmcnt(0)":::"memory"); \
      _Pragma("unroll") for(int d_=0;d_<2;++d_) _Pragma("unroll") for(int r=0;r<16;++r)o[d_][r]*=wsf[crow(r,hi)]; } }while(0)
  f32x16 pA0,pA1,pB0,pB1;
  int sl_prev=0,sl_cur=0,sl_next=SLOTB;
  #define ROT() do{sl_prev=sl_cur;sl_cur=sl_next;sl_next=(sl_next==(NSLOT-1)*SLOTB)?0:sl_next+SLOTB;}while(0)
  DMA_K(2,2*SLOTB);
  WAIT_BAR(3);
  if(BIAS){qkt(pA0,pA1,Kbase,qr,f32x16{},r32,hi);}else{qkt(pA0,pA1,Kbase,qr,negm,r32,hi);}asm volatile("s_nop 15\n\ts_nop 7":"+v"(pA0),"+v"(pA1));BIASADD(pA0,pA1,0);CMASK(pA0,pA1,0);
  START(pA0,pA1);
  _Pragma("unroll") for(int r=0;r<16;++r)pA1[r]=__builtin_amdgcn_exp2f(pA1[r]);
  WAIT_BAR(0);
  DMA_K(3,0);DMA_V(1,SLOTB);
  ROT();
  kload8(kf,kp0+sl_cur);
  WAIT_BAR(2);
  s16x4 vlo[8],vhi[8]; u32x4 pw0,pw1,pw2,pw3;
  #define PKW(P,B) cvtpk_s(P[B],P[B+1])
  #define PAF(k) __builtin_bit_cast(bf16x8,pw##k)
  #define VFR(i) (bf16x8){vlo[i][0],vlo[i][1],vlo[i][2],vlo[i][3],vhi[i][0],vhi[i][1],vhi[i][2],vhi[i][3]}
  #define PIN(x) asm volatile("":"+v"(x))
  #define MX3(a,b,c) __builtin_fmaxf(__builtin_fmaxf((a),(b)),(c))
  #define GAPA(MF,A0,A1,A2,A3,W0,W1,PW) do{ MF; sacc+=A0; sacc+=A1; sacc+=A2; sacc+=A3; PIN(sacc); W0; W1; PIN(PW); SBAR(); }while(0)
  #define EX(v) __builtin_amdgcn_exp2f(v)
  #define GAPB(MF,X,B) do{ MF; X[B]=EX(X[B]); X[B+1]=EX(X[B+1]); X[B+2]=EX(X[B+2]); X[B+3]=EX(X[B+3]); PIN(X); SBAR(); }while(0)
  #define VRD(i) do{ vlo[i]=vtr(vp_+(((i)>>2)*4096+((i)&3)*1024)); vhi[i]=vtr(vp_+(((i)>>2)*4096+((i)&3)*1024+512)); }while(0)
  #define KRD(G,j) do{ if(G){ kload2(kf,kp0+sl_next,j); SBAR(); } }while(0)
  #define STEP(C0,C1,P0,P1,t,GK,GV,GL) do{ SBAR(); \
    const lds_cptr vp_=vp0+sl_prev; \
    VRD(0); SBAR(); float sacc=(P0[0]+P0[1]); \
    GAPA(C0=(BIAS?__builtin_amdgcn_mfma_f32_32x32x16_bf16(kf[0],qr[0],f32x16{},0,0,0):__builtin_amdgcn_mfma_f32_32x32x16_bf16(kf[0],qr[0],negm,0,0,0)), P0[2],P0[3],P0[4],P0[5],     pw0[0]=PKW(P0,0), pw0[1]=PKW(P0,2), pw0); \
    VRD(4); SBAR(); GAPA(C1=(BIAS?__builtin_amdgcn_mfma_f32_32x32x16_bf16(kf[1],qr[0],f32x16{},0,0,0):__builtin_amdgcn_mfma_f32_32x32x16_bf16(kf[1],qr[0],negm,0,0,0)), P0[6],P0[7],P0[8],P0[9],     pw0[2]=PKW(P0,4), pw0[3]=PKW(P0,6), pw0); \
    VRD(1); SBAR(); GAPA(C0=__builtin_amdgcn_mfma_f32_32x32x16_bf16(kf[2],qr[1],C0,0,0,0),   P0[10],P0[11],P0[12],P0[13], pw1[0]=PKW(P0,8), pw1[1]=PKW(P0,10), pw1); \
    VRD(5); SBAR(); GAPA(C1=__builtin_amdgcn_mfma_f32_32x32x16_bf16(kf[3],qr[1],C1,0,0,0),   P0[14],P0[15],P1[0],P1[1],   pw1[2]=PKW(P0,12),pw1[3]=PKW(P0,14), pw1); \
    VRD(2); SBAR(); GAPA(C0=__builtin_amdgcn_mfma_f32_32x32x16_bf16(kf[4],qr[2],C0,0,0,0),   P1[2],P1[3],P1[4],P1[5],     pw2[0]=PKW(P1,0), pw2[1]=PKW(P1,2), pw2); \
    VRD(6); SBAR(); GAPA(C1=__builtin_amdgcn_mfma_f32_32x32x16_bf16(kf[5],qr[2],C1,0,0,0),   P1[6],P1[7],P1[8],P1[9],     pw2[2]=PKW(P1,4), pw2[3]=PKW(P1,6), pw2); \
    VRD(3); SBAR(); GAPA(C0=__builtin_amdgcn_mfma_f32_32x32x16_bf16(kf[6],qr[3],C0,0,0,0),   P1[10],P1[11],P1[12],P1[13], pw3[0]=PKW(P1,8), pw3[1]=PKW(P1,10), pw3); \
    VRD(7); SBAR(); GAPA(C1=__builtin_amdgcn_mfma_f32_32x32x16_bf16(kf[7],qr[3],C1,0,0,0),   P1[14],P1[15],0.f,0.f,       pw3[2]=PKW(P1,12),pw3[3]=PKW(P1,14), pw3); \
    l_reg+=sacc; \
    if(GK){DMA_K((t)+3,sl_cur);} if(GV){DMA_V((t)+1,sl_next);} \
    BIASADD(C0,C1,t); CMASK(C0,C1,t); \
    if(!FIXED){ float a=MX3(C0[0],C0[1],C1[0]),b=MX3(C0[2],C0[3],C1[1]); a=MX3(a,C1[2],C1[3]); \
      _Pragma("unroll") for(int r=4;r<16;r+=4){a=MX3(a,C0[r],C0[r+1]);b=MX3(b,C0[r+2],C0[r+3]);a=MX3(a,C1[r],C1[r+1]);b=MX3(b,C1[r+2],C1[r+3]);} \
      float rm=__builtin_fmaxf(a,b); { auto rr=__builtin_amdgcn_permlane32_swap(__float_as_uint(rm),__float_as_uint(rm),false,false); rm=__builtin_fmaxf(__uint_as_float(rr[0]),__uint_as_float(rr[1])); } \
      resc=false; \
      if(__builtin_expect(__any(rm>(float)THRL),0)){ const float dl=__builtin_fmaxf(rm,0.f); mhat+=dl; \
        _Pragma("unroll") for(int r=0;r<16;++r){C0[r]-=dl;C1[r]-=dl;} \
        if(!BIAS){ _Pragma("unroll") for(int r=0;r<16;++r)negm[r]=-mhat; asm volatile("":"+v"(negm)); } \
        const float f=__builtin_amdgcn_exp2f(-dl); l_reg*=f; if(hi==0)wsf[r32]=f; resc=true; } } \
    SBAR(); \
    GAPB(o[0]=__builtin_amdgcn_mfma_f32_32x32x16_bf16(PAF(0),VFR(0),o[0],0,0,0), C0,0); \
    GAPB(o[1]=__builtin_amdgcn_mfma_f32_32x32x16_bf16(PAF(0),VFR(4),o[1],0,0,0), C0,4); \
    KRD(GL,0); GAPB(o[0]=__builtin_amdgcn_mfma_f32_32x32x16_bf16(PAF(1),VFR(1),o[0],0,0,0), C0,8); \
    KRD(GL,1); GAPB(o[1]=__builtin_amdgcn_mfma_f32_32x32x16_bf16(PAF(1),VFR(5),o[1],0,0,0), C0,12); \
    KRD(GL,2); GAPB(o[0]=__builtin_amdgcn_mfma_f32_32x32x16_bf16(PAF(2),VFR(2),o[0],0,0,0), C1,0); \
    KRD(GL,3); GAPB(o[1]=__builtin_amdgcn_mfma_f32_32x32x16_bf16(PAF(2),VFR(6),o[1],0,0,0), C1,4); \
    GAPB(o[0]=__builtin_amdgcn_mfma_f32_32x32x16_bf16(PAF(3),VFR(3),o[0],0,0,0), C1,8); \
    GAPB(o[1]=__builtin_amdgcn_mfma_f32_32x32x16_bf16(PAF(3),VFR(7),o[1],0,0,0), C1,12); \
    }while(0)
  int t=1;
  #undef CMASK
  #define CMASK(P0,P1,t) do{}while(0)
  for(;t+5<NT;t+=2){
    STEP(pB0,pB1,pA0,pA1,t,true,true,true);     WAIT_BAR(2); RESC(); ROT();
    STEP(pA0,pA1,pB0,pB1,t+1,true,true,true);   WAIT_BAR(2); RESC(); ROT();
  }
  #undef CMASK
  #define CMASK(P0,P1,t) do{ if(CAUSAL){int jb_=(t)-(NT-4); if(jb_>=0)cmask(P0,P1,jb_,qrel,hi);} }while(0)
  #define ENDW(tt) do{ if((tt)+3<NT){WAIT_BAR(2);} else if((tt)+2<NT){WAIT_BAR(1);} else {WAIT_BAR(0);} }while(0)
  for(;t+1<NT;t+=2){
    STEP(pB0,pB1,pA0,pA1,t,(t+3<NT),(t+1<NT),(t+1<NT));       ENDW(t);   RESC(); ROT();
    STEP(pA0,pA1,pB0,pB1,t+1,(t+4<NT),(t+2<NT),(t+2<NT));     ENDW(t+1); RESC(); ROT();
  }
  STEP(pB0,pB1,pA0,pA1,NT-1,false,false,false); RESC();
  { float sacc=pB0[0]+pB0[1]; _Pragma("unroll") for(int r=2;r<16;++r)sacc+=pB0[r]; _Pragma("unroll") for(int r=0;r<16;++r)sacc+=pB1[r]; l_reg+=sacc;
    pw0=(u32x4){PKW(pB0,0),PKW(pB0,2),PKW(pB0,4),PKW(pB0,6)};pw1=(u32x4){PKW(pB0,8),PKW(pB0,10),PKW(pB0,12),PKW(pB0,14)};pw2=(u32x4){PKW(pB1,0),PKW(pB1,2),PKW(pB1,4),PKW(pB1,6)};pw3=(u32x4){PKW(pB1,8),PKW(pB1,10),PKW(pB1,12),PKW(pB1,14)};
    SBAR(); pv(o,vb0+sl_cur,PAF(0),PAF(1),PAF(2),PAF(3)); }
  #undef PKW
  #undef PAF
  #undef VFR
  #undef PIN
  #undef MX3
  #undef GAPA
  #undef GAPB
  #undef EX
  #undef VRD
  #undef KRD
  #undef STEP
  #undef ENDW
  int tid_e=threadIdx.x; asm volatile("":"+v"(tid_e)); const int lane_e=tid_e&63,r32_e=lane_e&31,hi_e=lane_e>>5; float*wsf_e=(float*)(shm+LDS_WS)+wid*64;
  {auto rr=__builtin_amdgcn_permlane32_swap(__float_as_uint(l_reg),__float_as_uint(l_reg),false,false);l_reg=__uint_as_float(rr[0])+__uint_as_float(rr[1]);}
  if(hi_e==0)wsf_e[32+r32_e]=l_reg;asm volatile("s_waitcnt lgkmcnt(0)":::"memory");
  float rli[16];
  #pragma unroll
  for(int r=0;r<16;++r)rli[r]=__builtin_amdgcn_rcpf(wsf_e[32+crow(r,hi_e)]);
  bf16*Ow=Ob+(long)(wid*QBLK)*OP;
  { bf16*stg=(bf16*)(shm+LDS_OST)+wid*2048;
    #pragma unroll
    for(int r=0;r<16;++r){const int orow=crow(r,hi_e);
      #pragma unroll
      for(int d0=0;d0<2;++d0)stg[orow*64+d0*32+r32_e]=__float2bfloat16(o[d0][r]*rli[r]);}
    asm volatile("s_waitcnt lgkmcnt(0)":::"memory");
    #pragma unroll
    for(int i=0;i<4;++i){const int row=i*8+(lane_e>>3),ch=lane_e&7; const u32x4 v=*(const u32x4*)(stg+row*64+ch*8); ATTN_STORE16(Ow+(long)row*OP+ch*8,v);} }
  asm volatile("s_waitcnt lgkmcnt(0)\n\ts_barrier":::"memory");
  #undef DMA_K
  #undef DMA_V
  #undef CMASK
  #undef BIASADD
  #undef START
  #undef RESC
  #undef ROT
}
constexpr int ATTN_LDS_BYTES=LDS_BYTES;
#undef SBAR
#undef WAIT_BAR
}
#define GAS __attribute__((address_space(1)))
#define LAS __attribute__((address_space(3)))
typedef unsigned short bf16;
typedef unsigned v4u __attribute__((ext_vector_type(4)));
typedef unsigned v2u __attribute__((ext_vector_type(2)));
typedef float f32x4 __attribute__((ext_vector_type(4)));
typedef short bf16x8 __attribute__((ext_vector_type(8)));
typedef float f32x16 __attribute__((ext_vector_type(16)));
#define LDS_WAIT() asm volatile("s_waitcnt lgkmcnt(0)" ::: "memory")

constexpr int NWAVES = 8;
constexpr int M = 32768, DM = 1024, FF = 2816, SEQ = 8192, NBATCH = 4, MEML = 256;
constexpr int NFOX = 2560, NFOX_SRC = 2572, NGM = 1792;
constexpr float EPS = 1e-6f;
constexpr size_t MiB = 1u << 20;
constexpr size_t WS_WFI = 1 * MiB;
constexpr size_t WS_WFO = 45 * MiB;
constexpr size_t WS_WFOX = 67 * MiB;
constexpr size_t WS_WGM = 72 * MiB;
constexpr size_t WS_WOUT = 76 * MiB;
constexpr size_t WS_WMKV = 80 * MiB;
constexpr size_t WS_WSB = 82 * MiB;
constexpr size_t WS_MEMN = 83 * MiB;
constexpr size_t WS_KVM = 85 * MiB;
constexpr size_t WS_LOGF = 87 * MiB;
constexpr size_t WS_BIAS = 89 * MiB;
constexpr size_t WS_SSQ = 91 * MiB;
constexpr size_t WS_XN = 96 * MiB;
constexpr size_t WS_CAT = 160 * MiB;
constexpr size_t WS_G = 224 * MiB;
constexpr size_t WS_END = 400 * MiB;
constexpr int LDS_BYTES = 132096;

__device__ __forceinline__ unsigned f2bf(float f) { unsigned u = __builtin_bit_cast(unsigned, f); return (u + 0x7fffu + ((u >> 16) & 1u)) >> 16; }
__device__ __forceinline__ unsigned pk2(float lo, float hi) { return f2bf(lo) | (f2bf(hi) << 16); }
__device__ __forceinline__ float bf2f(unsigned short b) { return __builtin_bit_cast(float, (unsigned)b << 16); }
__device__ __forceinline__ float wave_sum(float v) {
#pragma unroll
    for (int o = 1; o < 64; o <<= 1) v += __shfl_xor(v, o);
    return v;
}

__device__ __forceinline__ void conv_item(const float* W, int K, int Nsrc, int sc0, bf16* WTrow0, int k0, LAS float* scr, int lane, const float* gain = nullptr) {
    {
        f32x4 w[8]; const int c4 = lane & 7;
#pragma unroll
        for (int i = 0; i < 8; ++i) w[i] = *(const f32x4*)(W + (size_t)(k0 + 8 * i + (lane >> 3)) * Nsrc + sc0 + 4 * c4);
#pragma unroll
        for (int i = 0; i < 8; ++i) { const int kk = 8 * i + (lane >> 3); const float gk = gain ? gain[k0 + kk] : 1.0f; LAS float* d = scr + kk * 33 + 4 * c4;
            d[0] = w[i].x * gk; d[1] = w[i].y * gk; d[2] = w[i].z * gk; d[3] = w[i].w * gk; }
    }
    LDS_WAIT(); asm volatile("" ::: "memory");
    const int c = lane & 7;
#pragma unroll
    for (int j = 0; j < 4; ++j) { const int n = (lane >> 3) + 8 * j; const LAS float* s = scr + (8 * c) * 33 + n;
        v4u o; o.x = pk2(s[0 * 33], s[1 * 33]); o.y = pk2(s[2 * 33], s[3 * 33]); o.z = pk2(s[4 * 33], s[5 * 33]); o.w = pk2(s[6 * 33], s[7 * 33]);
        *(v4u*)(WTrow0 + (size_t)n * K + k0 + 8 * c) = o; }
    LDS_WAIT(); asm volatile("" ::: "memory");
}
__device__ __forceinline__ int map_plain(int n0) { return n0; }
__device__ __forceinline__ int map_swiglu(int n0) { const int t = n0 >> 8, j = n0 & 255; return (j < 128) ? 128 * t + j : FF + 128 * t + (j - 128); }
__device__ __forceinline__ int map_head(int n0, int gap_tile, int gap) { const int t = n0 >> 8, p = n0 & 255, bj = p >> 7, wc = (p >> 5) & 3; return 256 * t + 64 * wc + 32 * bj + (t >= gap_tile ? gap : 0); }

struct Args { const float* in[22]; float* out; unsigned char* ws; };

__device__ __forceinline__ void norm_row(const float* xrow, const f32x4 (&gn)[4], bf16* orow, int lane, f32x4 (&v)[4]) {
    const f32x4* xr = (const f32x4*)xrow + lane; float s = 0.f;
#pragma unroll
    for (int j = 0; j < 4; ++j) { v[j] = xr[64 * j]; s += (v[j].x * v[j].x + v[j].y * v[j].y) + (v[j].z * v[j].z + v[j].w * v[j].w); }
    const float rstd = 1.0f / sqrtf(wave_sum(s) * (1.f / DM) + EPS);
    unsigned long long* o8 = (unsigned long long*)orow + lane;
#pragma unroll
    for (int j = 0; j < 4; ++j) { v[j] = v[j] * rstd * gn[j]; o8[64 * j] = (unsigned long long)pk2(v[j].x, v[j].y) | ((unsigned long long)pk2(v[j].z, v[j].w) << 32); }
}

__device__ __forceinline__ void gmlp_unit(int rc, int g, const bf16* PROJ, const bf16* WSB, const float* bs, bf16* CAT, LAS unsigned char* lds, int tid_in) {
    int tid = tid_in; asm volatile("" : "+v"(tid));
    const int lane = tid & 63, wid = tid >> 6, r32 = lane & 31, hi = lane >> 5;
    LAS bf16* VT = (LAS bf16*)lds;
    {
        const int row = tid >> 2, seg = tid & 3;
        const bf16* src = PROJ + (size_t)(rc * 128 + row) * NGM + 768 + g * 64 + seg * 16;
        const bf16x8 a = *(const bf16x8*)src, b = *(const bf16x8*)(src + 8);
#pragma unroll
        for (int e = 0; e < 8; ++e) { VT[(seg * 16 + e) * 136 + row] = (bf16)a[e]; VT[(seg * 16 + 8 + e) * 136 + row] = (bf16)b[e]; }
    }
    __syncthreads();
    const int tb = wid & 3, db = wid >> 2;
    f32x16 acc; { float z0_; asm volatile("v_mov_b32 %0, 0" : "=v"(z0_));
#pragma unroll
      for (int r = 0; r < 16; ++r) acc[r] = z0_; }
    const bf16* wrow = WSB + ((size_t)g * 128 + tb * 32 + r32) * 128 + 8 * hi;
    const LAS bf16* vrow = VT + (db * 32 + r32) * 136 + 8 * hi;
    const int nks = 2 * (tb + 1);
    for (int ks = 0; ks < nks; ++ks) {
        const bf16x8 A = *(const LAS bf16x8*)(vrow + 16 * ks); const bf16x8 Bf = *(const bf16x8*)(wrow + 16 * ks);
        acc = __builtin_amdgcn_mfma_f32_32x32x16_bf16(A, Bf, acc, 0, 0, 0);
    }
    const int t = tb * 32 + r32; const float bsv = bs[g * 128 + t];
    const size_t row = (size_t)rc * 128 + t;
    const bf16* up = PROJ + row * NGM + g * 64 + db * 32 + 4 * hi;
    bf16* op = CAT + row * DM + g * 64 + db * 32 + 4 * hi;
#pragma unroll
    for (int q = 0; q < 4; ++q) {
        const v2u uv = *(const v2u*)(up + 8 * q);
        const float u0 = __builtin_bit_cast(float, uv.x << 16), u1 = __builtin_bit_cast(float, uv.x & 0xffff0000u), u2 = __builtin_bit_cast(float, uv.y << 16), u3 = __builtin_bit_cast(float, uv.y & 0xffff0000u);
        v2u o; o.x = pk2(u0 * (acc[4 * q] + bsv), u1 * (acc[4 * q + 1] + bsv)); o.y = pk2(u2 * (acc[4 * q + 2] + bsv), u3 * (acc[4 * q + 3] + bsv));
        *(v2u*)(op + 8 * q) = o;
    }
    __syncthreads();
}

#define CW_XCNT(j) (128 + 64 * (j))
#define CW_XSUB(j) (128 + 64 * 16 + 64 * (j))
#define CW_TOP (128 + 64 * 32)
constexpr int CTL_BYTES = 16384;
__device__ __forceinline__ unsigned xcc_id() { return (unsigned)__builtin_amdgcn_s_getreg((3 << 11) | 20) & 0xFu; }
__device__ __forceinline__ void grid_bar(unsigned* ctl, volatile LAS unsigned* st, unsigned k, unsigned G) {
    asm volatile("s_waitcnt vmcnt(0)" ::: "memory");
    __syncthreads();
    int t = threadIdx.x; asm volatile("" : "+v"(t));
    if (t == 0) {
        const unsigned x = st[0]; unsigned nloc = st[1];
        if (nloc == 0u) {
            for (;;) { unsigned sum = 0u, mine = 0u;
#pragma unroll
                for (unsigned j = 0; j < 16; ++j) { const unsigned c = __hip_atomic_load(ctl + CW_XCNT(j), __ATOMIC_RELAXED, __HIP_MEMORY_SCOPE_AGENT); sum += c; mine = (j == x) ? c : mine; }
                if (sum == G) { nloc = mine; break; } __builtin_amdgcn_s_sleep(2); }
            st[1] = nloc;
        }
        const unsigned old = __hip_atomic_fetch_add(ctl + CW_XSUB(x), 1u, __ATOMIC_RELAXED, __HIP_MEMORY_SCOPE_AGENT);
        if (old + 1u == k * nloc) {
            __builtin_amdgcn_fence(__ATOMIC_RELEASE, "agent");
            asm volatile("s_waitcnt vmcnt(0)" ::: "memory");
            __hip_atomic_fetch_add(ctl + CW_TOP, nloc, __ATOMIC_RELAXED, __HIP_MEMORY_SCOPE_AGENT);
        }
        while (__hip_atomic_load(ctl + CW_TOP, __ATOMIC_RELAXED, __HIP_MEMORY_SCOPE_AGENT) < k * G) __builtin_amdgcn_s_sleep(2);
        __builtin_amdgcn_fence(__ATOMIC_ACQUIRE, "agent");
        asm volatile("s_waitcnt vmcnt(0)" ::: "memory");
    }
    __syncthreads();
}
__global__ void __launch_bounds__(NWAVES * 64, 2) fwd_megakernel(Args args) {
    extern __shared__ __attribute__((aligned(16))) unsigned char lds[];
    cg::grid_group grid = cg::this_grid();
    LAS unsigned char* ldsl = (LAS unsigned char*)lds;
    const int tid = threadIdx.x, lane = tid & 63, wave = __builtin_amdgcn_readfirstlane(tid >> 6);
    const int G = gridDim.x, bx = blockIdx.x;
    const int vcu = (G % 8 == 0) ? (bx % 8) * (G / 8) + bx / 8 : bx;
    const int gw = vcu * NWAVES + wave, NGW = G * NWAVES;
    unsigned char* ws = args.ws;
    const float* x_in = args.in[0]; float* xres = args.out;
#define WFI ((bf16*)(wsl() + WS_WFI))
#define WFO ((bf16*)(wsl() + WS_WFO))
#define WFOX ((bf16*)(wsl() + WS_WFOX))
#define WGM ((bf16*)(wsl() + WS_WGM))
#define WOUT ((bf16*)(wsl() + WS_WOUT))
#define WMKV ((bf16*)(wsl() + WS_WMKV))
#define WSB ((bf16*)(wsl() + WS_WSB))
#define MEMN ((bf16*)(wsl() + WS_MEMN))
#define KVM ((bf16*)(wsl() + WS_KVM))
#define LOGF ((float*)(wsl() + WS_LOGF))
#define BIASA ((float*)(wsl() + WS_BIAS))
#define XN ((bf16*)(wsl() + WS_XN))
#define SSQ ((float*)(wsl() + WS_SSQ))
#define CAT ((bf16*)(wsl() + WS_CAT))
#define GB ((bf16*)(wsl() + WS_G))
    auto wsl = [&]() __attribute__((always_inline)) { unsigned char* p = ws; asm volatile("" : "+s"(p)); return p; };

    volatile LAS unsigned* bst = (volatile LAS unsigned*)(ldsl + 131072 + 16);
    if (bx == 0) for (int i = tid; i < CTL_BYTES / 4; i += NWAVES * 64) ((unsigned*)wsl())[i] = 0u;
    asm volatile("s_waitcnt vmcnt(0)" ::: "memory"); __syncthreads();
    grid.sync();
    if (tid == 0) { const unsigned x_ = xcc_id(); bst[0] = x_; bst[1] = 0u; __hip_atomic_fetch_add((unsigned*)wsl() + CW_XCNT(x_), 1u, __ATOMIC_RELAXED, __HIP_MEMORY_SCOPE_AGENT); }
    unsigned nbar = 0;
#define GBAR() do { ++nbar; grid_bar((unsigned*)wsl(), bst, nbar, (unsigned)G); } while (0)
    {
        LAS float* scr = (LAS float*)(ldsl + wave * 16384);
        constexpr int I_FI = 16 * 176, I_FO = 44 * 32, I_FOX = 16 * 80, I_GM = 16 * 56, I_WO = 16 * 32, I_KV = 16 * 16;
        constexpr int NITEMS = 4 * I_FI + 4 * I_FO + I_FOX + I_GM + 2 * I_WO + 2 * I_KV;
        for (int it = gw; it < NITEMS; it += NGW) {
            int r = it;
            if (r < 4 * I_FI) { const int mi = r / I_FI; r -= mi * I_FI; const int layer = mi >> 1, which = mi & 1; const int kb = r / 176, nb = r % 176;
                const float* W = args.in[which ? 7 : 3] + (size_t)layer * DM * 2 * FF;
                conv_item(W, DM, 2 * FF, map_swiglu(32 * nb), WFI + (size_t)mi * 5632 * DM + (size_t)(32 * nb) * DM, 64 * kb, scr, lane, args.in[which ? 6 : 2] + layer * DM); continue; }
            r -= 4 * I_FI;
            if (r < 4 * I_FO) { const int mi = r / I_FO; r -= mi * I_FO; const int layer = mi >> 1, which = mi & 1; const int kb = r / 32, nb = r % 32;
                const float* W = args.in[which ? 8 : 4] + (size_t)layer * FF * DM;
                conv_item(W, FF, DM, map_plain(32 * nb), WFO + (size_t)mi * DM * FF + (size_t)(32 * nb) * FF, 64 * kb, scr, lane); continue; }
            r -= 4 * I_FO;
            if (r < I_FOX) { const int kb = r / 80, nb = r % 80;
                conv_item(args.in[14], DM, NFOX_SRC, map_head(32 * nb, 9, 12), WFOX + (size_t)(32 * nb) * DM, 64 * kb, scr, lane, args.in[5]); continue; }
            r -= I_FOX;
            if (r < I_GM) { const int kb = r / 56, nb = r % 56;
                conv_item(args.in[18], DM, NGM, map_head(32 * nb, 99, 0), WGM + (size_t)(32 * nb) * DM, 64 * kb, scr, lane, args.in[5] + DM); continue; }
            r -= I_GM;
            if (r < 2 * I_WO) { const int mi = r / I_WO; r -= mi * I_WO; const int kb = r / 32, nb = r % 32;
                conv_item(args.in[9] + (size_t)mi * DM * DM, DM, DM, map_plain(32 * nb), WOUT + (size_t)mi * DM * DM + (size_t)(32 * nb) * DM, 64 * kb, scr, lane); continue; }
            r -= 2 * I_WO;
            { const int mi = r / I_KV; r -= mi * I_KV; const int kb = r / 16, nb = r % 16;
                conv_item(args.in[11] + (size_t)mi * DM * 512, DM, 512, map_head(32 * nb, 99, 0), WMKV + (size_t)mi * 512 * DM + (size_t)(32 * nb) * DM, 64 * kb, scr, lane); }
        }
        for (int i = bx * (NWAVES * 64) + tid; i < 12 * 128 * 128; i += G * NWAVES * 64) { const int s = i & 127, t = (i >> 7) & 127; WSB[i] = (s <= t) ? (bf16)f2bf(args.in[20][i]) : (bf16)0; }
        { f32x4 gn[4], v[4];
#pragma unroll
          for (int j = 0; j < 4; ++j) gn[j] = ((const f32x4*)args.in[10])[lane + 64 * j];
          for (int m = gw; m < NBATCH * MEML; m += NGW) norm_row(args.in[1] + (size_t)m * DM, gn, MEMN + (size_t)m * DM, lane, v); }
        for (int m = gw; m < M; m += NGW) {
            const f32x4* xr = (const f32x4*)(args.in[0] + (size_t)m * DM) + lane; unsigned long long* o8 = (unsigned long long*)(XN + (size_t)m * DM) + lane; float ss = 0.f;
#pragma unroll
            for (int j = 0; j < 4; ++j) { const f32x4 v = xr[64 * j]; ss += (v.x * v.x + v.y * v.y) + (v.z * v.z + v.w * v.w); o8[64 * j] = (unsigned long long)pk2(v.x, v.y) | ((unsigned long long)pk2(v.z, v.w) << 32); }
            ss = wave_sum(ss); if (lane == 0) SSQ[m] = ss;
        }
        for (int i = bx * (NWAVES * 64) + tid; i < 5 * M; i += G * NWAVES * 64) SSQ[M + i] = 0.f;
        __syncthreads();
    }

    GBAR();
#pragma nounroll
    for (int half = 0; half < 4; ++half) {
        const int layer = half >> 1, which = half & 1;
        int tid = threadIdx.x; asm volatile("" : "+v"(tid)); const int lane = tid & 63;
        const float* xin = (half == 0) ? x_in : xres;
        { pg8::Gemm g{XN, WFI + (size_t)half * 5632 * DM, M, 2 * FF, DM}; pg8::StaticOrder S; S.init(M, 2 * FF, G, bx);
          pg8::EpiSwiGLU E{GB, FF, SSQ + (size_t)(layer * 3 + (which ? 2 : 0)) * M};
          pg8::gemm_phase<pg8::EpiSwiGLU, pg8::StaticOrder, true, true>(ldsl, g, S, E); }
        GBAR();
        { pg8::Gemm g{GB, WFO + (size_t)half * DM * FF, M, DM, FF}; pg8::StaticOrder S; S.init(M, DM, G, bx);
          if (half == 3) { pg8::EpiRes<false> E{xin, xres, nullptr, nullptr, 0.5f}; pg8::gemm_phase<pg8::EpiRes<false>, pg8::StaticOrder, true, true>(ldsl, g, S, E); break; }
          pg8::EpiRes<true> E{xin, xres, XN, SSQ + (size_t)(layer * 3 + (which ? 3 : 1)) * M, 0.5f};
          pg8::gemm_phase<pg8::EpiRes<true>, pg8::StaticOrder, true, true>(ldsl, g, S, E); }
        GBAR();
        if (which == 1) continue;
        const float* ssq_mix = SSQ + (size_t)(layer * 3 + 1) * M;
        if (layer == 0) {
#pragma nounroll
            for (int l2 = 0; l2 < 2; ++l2) {
                pg8::Gemm g{MEMN, WMKV + (size_t)l2 * 512 * DM, NBATCH * MEML, 512, DM}; pg8::StaticOrder S; S.init(NBATCH * MEML, 512, G, (bx + G - 8 * l2) % G);
                pg8::EpiProj<2> E{KVM + (size_t)l2 * 1024 * 512, 512, nullptr, args.in[13] + l2 * 64, nullptr, nullptr};
                pg8::gemm_phase<pg8::EpiProj<2>, pg8::StaticOrder, true, true>(ldsl, g, S, E);
                __syncthreads();
            }
            {
                LAS float* FWT = (LAS float*)ldsl;
                for (int i = tid; i < 12 * DM; i += NWAVES * 64) { const int h = i % 12, k = i / 12; FWT[h * DM + k] = args.in[14][(size_t)k * NFOX_SRC + 2304 + h] * args.in[5][k]; }
                __syncthreads();
                const float bfl = (lane < 12) ? args.in[15][lane] : 0.f;
                int gwl = gw; asm volatile("" : "+s"(gwl));
                for (int m = gwl; m < M; m += NGW) {
                    const v4u xa = *((const v4u*)(XN + (size_t)m * DM) + lane), xc = *((const v4u*)(XN + (size_t)m * DM + 512) + lane);
                    float xv[16];
#pragma unroll
                    for (int e = 0; e < 4; ++e) { xv[2 * e] = __builtin_bit_cast(float, xa[e] << 16); xv[2 * e + 1] = __builtin_bit_cast(float, xa[e] & 0xffff0000u);
                                                  xv[8 + 2 * e] = __builtin_bit_cast(float, xc[e] << 16); xv[8 + 2 * e + 1] = __builtin_bit_cast(float, xc[e] & 0xffff0000u); }
                    float fl = 0.f;
#pragma unroll
                    for (int h = 0; h < 12; ++h) {
                        const LAS f32x4* wp = (const LAS f32x4*)(FWT + h * DM + 8 * lane);
                        const f32x4 w0 = wp[0], w1 = wp[1], w2 = wp[128], w3 = wp[129];
                        float p = ((xv[0] * w0.x + xv[1] * w0.y) + (xv[2] * w0.z + xv[3] * w0.w)) + ((xv[4] * w1.x + xv[5] * w1.y) + (xv[6] * w1.z + xv[7] * w1.w))
                                + ((xv[8] * w2.x + xv[9] * w2.y) + (xv[10] * w2.z + xv[11] * w2.w)) + ((xv[12] * w3.x + xv[13] * w3.y) + (xv[14] * w3.z + xv[15] * w3.w));
                        p = wave_sum(p); if (lane == h) fl = p;
                    }
                    if (lane < 12) { const float rs = 1.0f / sqrtf(ssq_mix[m] * (1.0f / 1024.0f) + EPS); const float f = fl * rs + bfl;
                        const float lf = fminf(f, 0.f) - 0.6931471805599453f * __builtin_amdgcn_logf(1.0f + __builtin_amdgcn_exp2f(-1.4426950408889634f * fabsf(f)));
                        LOGF[(size_t)((m >> 13) * 12 + lane) * SEQ + (m & (SEQ - 1))] = lf; }
                }
                __syncthreads();
            }
            { pg8::Gemm g{XN, WFOX, M, NFOX, DM}; pg8::StaticOrder S; S.init(M, NFOX, G, bx);
              pg8::EpiProj<0> E{GB, NFOX, args.in[16], args.in[17], args.in[12], ssq_mix};
              pg8::gemm_phase<pg8::EpiProj<0>, pg8::StaticOrder, true, true>(ldsl, g, S, E); }
            GBAR();
            if (bx < 48) {
                LAS double* sw = (LAS double*)ldsl;
                const f32x4* lf4 = (const f32x4*)(LOGF + (size_t)bx * SEQ) + tid * 4;
                double loc[16]; double run = 0.0;
#pragma unroll
                for (int j = 0; j < 4; ++j) { const f32x4 q = lf4[j]; run += (double)q.x; loc[4 * j] = run; run += (double)q.y; loc[4 * j + 1] = run; run += (double)q.z; loc[4 * j + 2] = run; run += (double)q.w; loc[4 * j + 3] = run; }
                double sc = run;
#pragma unroll
                for (int o = 1; o < 64; o <<= 1) { const double y = __shfl_up(sc, o); if (lane >= o) sc += y; }
                if (lane == 63) sw[wave] = sc;
                __syncthreads();
                double woff = 0.0;
                for (int w2 = 0; w2 < wave; ++w2) woff += sw[w2];
                const double excl = sc - run + woff;
                f32x4* bo = (f32x4*)(BIASA + (size_t)bx * SEQ) + tid * 4;
#pragma unroll
                for (int j = 0; j < 4; ++j) { f32x4 o; o.x = (float)(-(excl + loc[4 * j]) * 1.4426950408889634); o.y = (float)(-(excl + loc[4 * j + 1]) * 1.4426950408889634);
                    o.z = (float)(-(excl + loc[4 * j + 2]) * 1.4426950408889634); o.w = (float)(-(excl + loc[4 * j + 3]) * 1.4426950408889634); bo[j] = o; }
                __syncthreads();
            }
        } else {
            pg8::Gemm g{XN, WGM, M, NGM, DM}; pg8::StaticOrder S; S.init(M, NGM, G, bx);
            pg8::EpiProj<1> E{GB, NGM, nullptr, args.in[19], args.in[12] + 64, ssq_mix};
            pg8::gemm_phase<pg8::EpiProj<1>, pg8::StaticOrder, true, true>(ldsl, g, S, E);
        }
        GBAR();
        if (layer == 0) {
            const attn_body::bf16* P = (const attn_body::bf16*)GB; attn_body::bf16* C = (attn_body::bf16*)CAT;
            float mq = fabsf(args.in[16][lane]), mk = fabsf(args.in[17][lane]);
#pragma unroll
            for (int o = 1; o < 64; o <<= 1) { mq = fmaxf(mq, __shfl_xor(mq, o)); mk = fmaxf(mk, __shfl_xor(mk, o)); }
            const float bound = __builtin_bit_cast(float, __builtin_amdgcn_readfirstlane(__builtin_bit_cast(int, 64.f * pg8::ATT_C2 * mq * mk * 1.02f + 0.25f)));
            const bool fixed_ok = bound <= 60.f;
            unsigned* qctr = (unsigned*)wsl();
            LAS int* qslot = (LAS int*)(ldsl + 131072);
            for (;;) {
                int tidq = threadIdx.x; asm volatile("" : "+v"(tidq)); const int laneq = tidq & 63;
                if (tidq == 0) *qslot = (int)atomicAdd(qctr, 1u);
                __syncthreads();
                const int idx = __builtin_amdgcn_readfirstlane(*qslot);
                if (idx >= 1536 + 512) break;
                if (idx >= 1536) {
                    const int u = idx - 1536, bm = u >> 5, qb = u & 31, b = bm >> 2, mh = bm & 3; const size_t rowq = (size_t)b * SEQ + qb * 256;
                    const attn_body::bf16* KV = (const attn_body::bf16*)KVM;
                    attn_body::attn_unit<8, false, false, false, 512, DM>(P + rowq * NFOX + 2304 + mh * 64, NFOX, KV + (size_t)(b * MEML) * 512 + mh * 64, KV + (size_t)(b * MEML) * 512 + 256 + mh * 64,
                                                                      C + rowq * DM + 768 + mh * 64, 4, nullptr, nullptr, 0.f, (char*)lds);
                    continue;
                }
                const int qb = 31 - idx / 48, bh = idx % 48, b = bh / 12, h = bh % 12;
                const size_t rowq = (size_t)b * SEQ + qb * 256;
                const float* bb = BIASA + (size_t)bh * SEQ;
                const int NT = 4 * qb + 4;
                if (fixed_ok) {
                    const float bq0 = bb[qb * 256];
                    const int t1 = laneq, t2 = laneq + 64;
                    const bool n1 = (t1 < NT) && (2.f * bound + bb[64 * (t1 < NT ? t1 : 0) + 63] - bq0 >= -48.f);
                    const bool n2 = (t2 < NT) && (2.f * bound + bb[64 * (t2 < NT ? t2 : 0) + 63] - bq0 >= -48.f);
                    const unsigned long long m1 = __ballot(n1), m2 = __ballot(n2);
                    int first = m1 ? (__ffsll((long long)m1) - 1) : (m2 ? 64 + (__ffsll((long long)m2) - 1) : NT);
                    int T0 = first & ~1; if (T0 > NT - 4) T0 = NT - 4;
                    T0 = __builtin_amdgcn_readfirstlane(T0);
                    const size_t rowk = (size_t)b * SEQ + (size_t)T0 * 64;
                    attn_body::attn_unit<8, true, true, true, NFOX, DM>(P + rowq * NFOX + h * 64, NFOX, P + rowk * NFOX + 768 + h * 64, P + rowk * NFOX + 1536 + h * 64,
                                                                    C + rowq * DM + h * 64, NT - T0, bb + T0 * 64, bb + qb * 256, bound, (char*)lds);
                } else {
                    const size_t rowk = (size_t)b * SEQ;
                    attn_body::attn_unit<8, true, true, false, NFOX, DM>(P + rowq * NFOX + h * 64, NFOX, P + rowk * NFOX + 768 + h * 64, P + rowk * NFOX + 1536 + h * 64,
                                                                     C + rowq * DM + h * 64, NT, bb, nullptr, 0.f, (char*)lds);
                }
            }
        } else {
            for (int u = vcu; u < 256 * 12; u += G) gmlp_unit(u / 12, u % 12, GB, WSB, args.in[21], CAT, ldsl, tid);
        }
        if (layer == 1) {
            const int QP = layer == 0 ? NFOX : NGM; const int mqc = layer == 0 ? 2304 : 1536;
            const attn_body::bf16* P = (const attn_body::bf16*)GB; attn_body::bf16* C = (attn_body::bf16*)CAT; const attn_body::bf16* KV = (const attn_body::bf16*)(KVM + (size_t)layer * 1024 * 512);
            for (int u = vcu; u < 512; u += G) {
                const int bm = u >> 5, qb = u & 31, b = bm >> 2, mh = bm & 3; const size_t rowq = (size_t)b * SEQ + qb * 256;
                attn_body::attn_unit<8, false, false, false, 512, DM>(P + rowq * QP + mqc + mh * 64, QP, KV + (size_t)(b * MEML) * 512 + mh * 64, KV + (size_t)(b * MEML) * 512 + 256 + mh * 64,
                                                           C + rowq * DM + 768 + mh * 64, 4, nullptr, nullptr, 0.f, (char*)lds);
            }
        }
        GBAR();
        { pg8::Gemm g{CAT, WOUT + (size_t)layer * DM * DM, M, DM, DM}; pg8::StaticOrder S; S.init(M, DM, G, bx);
          pg8::EpiRes<true> E{xres, xres, XN, SSQ + (size_t)(layer * 3 + 2) * M, 1.0f};
          pg8::gemm_phase<pg8::EpiRes<true>, pg8::StaticOrder, true, true>(ldsl, g, S, E); }
        GBAR();
    }
}

extern "C" void kernel_launch(void* const* d_in, const int* in_sizes, int n_in, void* d_out, int out_size, void* d_ws, size_t ws_size, hipStream_t stream) {
    static int grid_blocks = 0;
    if (grid_blocks == 0) {
        if (n_in != 22 || out_size != M * DM || ws_size < WS_END) { fprintf(stderr, "kernel_launch: unexpected problem (n_in %d, out %d, ws %zu)\n", n_in, out_size, ws_size); grid_blocks = -1; return; }
        int dev = 0, cus = 0, per_cu = 0;
        hipGetDevice(&dev);
        hipDeviceGetAttribute(&cus, hipDeviceAttributeMultiprocessorCount, dev);
        if (hipFuncSetAttribute((const void*)fwd_megakernel, hipFuncAttributeMaxDynamicSharedMemorySize, LDS_BYTES) != hipSuccess) { fprintf(stderr, "kernel_launch: hipFuncSetAttribute failed\n"); grid_blocks = -1; return; }
        if (hipOccupancyMaxActiveBlocksPerMultiprocessor(&per_cu, (const void*)fwd_megakernel, NWAVES * 64, LDS_BYTES) != hipSuccess || per_cu < 1) { fprintf(stderr, "kernel_launch: occupancy query gave %d\n", per_cu); per_cu = 1; }
        (void)hipGetLastError();
        grid_blocks = cus * per_cu;
        if (grid_blocks > 256) grid_blocks = 256;
    }
    if (grid_blocks < 0) return;
    Args a{};
    for (int i = 0; i < 22; ++i) a.in[i] = (const float*)d_in[i];
    a.out = (float*)d_out; a.ws = (unsigned char*)d_ws;
    void* kargs[] = {&a};
    hipError_t e = hipLaunchCooperativeKernel((const void*)fwd_megakernel, dim3(grid_blocks), dim3(NWAVES * 64), kargs, LDS_BYTES, stream);
    if (e != hipSuccess) fprintf(stderr, "cooperative launch failed: %s (grid %d)\n", hipGetErrorString(e), grid_blocks);
}
```
